# Optimizing an MI355X kernel written in HIP

```python
import math
import jax, jax.numpy as jnp
from jax import lax
import numpy as np

D_MODEL = 2048
BATCH = 4
SEQ = 2048
DEPTH = 2

N_EVEN = (DEPTH + 1) // 2
N_ODD = DEPTH // 2

NSA_HEADS = 8
NSA_GROUPS = 2
NSA_HPG = NSA_HEADS // NSA_GROUPS
NSA_DIM = 128
CMP_LEN = 32
CMP_STRIDE = 16
SEL_LEN = 64
N_SELECT = 8
WINDOW = 512

DIFF_HEADS = 8
DIFF_QK = 64
DIFF_V = 2 * DIFF_QK

RET_HEADS = 8
RET_QK = 256
RET_V = 512
RET_CHUNK = 128
ROPE_BASE = 10000.0

D_FF = 5632

NUM_BUCKETS = 32
MAX_DISTANCE = 128
ATT_HEADS = NSA_HEADS + DIFF_HEADS

Q_BLOCK = 128
ALPHA = (2 * DEPTH) ** 0.25
BETA = (8 * DEPTH) ** -0.25
LN_EPS = 1e-5
NEG = -1e30

A_SPLITS = [NSA_HEADS * NSA_DIM] + [NSA_GROUPS * NSA_DIM] * 6 + [NSA_HEADS * 3, DIFF_HEADS * 2 * DIFF_QK, DIFF_HEADS * 2 * DIFF_QK, DIFF_HEADS * DIFF_V]
A_WIDTH = sum(A_SPLITS)
MIX_A_OUT = NSA_HEADS * NSA_DIM + DIFF_HEADS * DIFF_V
RET_SPLITS = [RET_HEADS * RET_QK, RET_HEADS * RET_QK, RET_HEADS * RET_V, RET_HEADS * RET_V]
RET_WIDTH = sum(RET_SPLITS)

kernel_name = "hybrid_nsa_diff_retention_macaron"


def _split(y, sizes):
    idx = np.cumsum(sizes)[:-1].tolist()
    return jnp.split(y, idx, axis=-1)


def layer_norm(x, g, b):
    xf = x.astype(jnp.float32)
    mu = jnp.mean(xf, -1, keepdims=True)
    var = jnp.mean(jnp.square(xf - mu), -1, keepdims=True)
    return ((xf - mu) * lax.rsqrt(var + LN_EPS) * g + b).astype(x.dtype)


def swiglu(x, w_in, w_out):
    gate, up = jnp.split(x @ w_in, 2, axis=-1)
    return (jax.nn.silu(gate) * up) @ w_out


def t5_bucket(dist):
    n = jnp.maximum(dist, 0)
    max_exact = NUM_BUCKETS // 2
    nf = jnp.maximum(n, 1).astype(jnp.float32)
    large = max_exact + (jnp.log(nf / max_exact) / math.log(MAX_DISTANCE / max_exact) * (NUM_BUCKETS - max_exact)).astype(jnp.int32)
    large = jnp.minimum(large, NUM_BUCKETS - 1)
    return jnp.where(n < max_exact, n, large)


def masked_softmax(s, mask):
    return jax.nn.softmax(jnp.where(mask, s.astype(jnp.float32), NEG), axis=-1)


def compress(kv, pos, w1, w2):
    B, T, G, dh = kv.shape
    nc = (T - CMP_LEN) // CMP_STRIDE + 1
    idx = np.arange(nc)[:, None] * CMP_STRIDE + np.arange(CMP_LEN)[None, :]
    blk = kv[:, idx] + pos[:, None, :]
    blk = blk.transpose(0, 1, 3, 2, 4).reshape(B, nc, G, CMP_LEN * dh)
    return jax.nn.gelu(blk @ w1) @ w2


def cmp_to_sel_matrix(nc, ns):
    start = np.arange(nc) * CMP_STRIDE
    end = start + CMP_LEN
    s0 = np.arange(ns) * SEL_LEN
    s1 = s0 + SEL_LEN
    ov = np.clip(np.minimum(end[:, None], s1[None, :]) - np.maximum(start[:, None], s0[None, :]), 0, None)
    return (ov / CMP_LEN).astype(np.float32)


def nsa_attention(q, kc, vc, ks, vs, kw, vw, gates, bias_tab, pos_k, w1_k, w2_k, pos_v, w1_v, w2_v):
    B, T, H, dh = q.shape
    G, HPG = NSA_GROUPS, NSA_HPG
    scale = dh ** -0.5
    qg = q.reshape(B, T, G, HPG, dh)
    tpos = jnp.arange(T)
    nq = T // Q_BLOCK

    kcmp = compress(kc, pos_k, w1_k, w2_k)
    vcmp = compress(vc, pos_v, w1_v, w2_v)
    nc = kcmp.shape[1]
    blk_end = jnp.arange(nc) * CMP_STRIDE + CMP_LEN - 1
    dist = tpos[:, None] - blk_end[None, :]
    bias = bias_tab[t5_bucket(dist)].reshape(T, nc, G, HPG).transpose(2, 3, 0, 1)
    s = jnp.einsum('btghd,bcgd->bghtc', qg, kcmp) * scale + bias
    p = masked_softmax(s, dist >= 0) * (tpos >= CMP_LEN - 1).astype(jnp.float32)[:, None]
    o_cmp = jnp.einsum('bghtc,bcgd->btghd', p.astype(vcmp.dtype), vcmp).reshape(B, T, H, dh)

    ns = T // SEL_LEN
    m = jnp.asarray(cmp_to_sel_matrix(nc, ns))
    imp = jnp.einsum('bghtc,cj->bgtj', p, m)
    jblk = jnp.arange(ns)[None, :]
    tblk = (tpos // SEL_LEN)[:, None]
    forced = (jblk == 0) | (jblk == tblk) | (jblk == tblk - 1)
    score = jnp.where(jblk > tblk, -jnp.inf, jnp.where(forced, jnp.inf, imp))
    n_sel = min(N_SELECT, ns)
    _, sel = lax.top_k(score, n_sel)

    kb = ks.reshape(B, ns, SEL_LEN, G, dh).transpose(0, 3, 1, 2, 4)
    vb = vs.reshape(B, ns, SEL_LEN, G, dh).transpose(0, 3, 1, 2, 4)
    gather = jax.vmap(jax.vmap(lambda blocks, ix: blocks[ix]))
    tab_g = bias_tab.reshape(NUM_BUCKETS, G, HPG).transpose(1, 0, 2)
    gidx = jnp.arange(G)[None, :, None, None]

    def sel_block(c):
        t0 = c * Q_BLOCK
        qc = lax.dynamic_slice_in_dim(qg, t0, Q_BLOCK, axis=1)
        ic = lax.dynamic_slice_in_dim(sel, t0, Q_BLOCK, axis=2)
        kg = gather(kb, ic).reshape(B, G, Q_BLOCK, n_sel * SEL_LEN, dh)
        vg = gather(vb, ic).reshape(B, G, Q_BLOCK, n_sel * SEL_LEN, dh)
        kpos = (ic[..., None] * SEL_LEN + jnp.arange(SEL_LEN)).reshape(B, G, Q_BLOCK, n_sel * SEL_LEN)
        d = (t0 + jnp.arange(Q_BLOCK))[None, None, :, None] - kpos
        bb = tab_g[gidx, t5_bucket(d)].transpose(0, 1, 4, 2, 3)
        sc = jnp.einsum('bqghd,bgqkd->bghqk', qc, kg) * scale + bb
        pp = masked_softmax(sc, (d >= 0)[:, :, None])
        return jnp.einsum('bghqk,bgqkd->bqghd', pp.astype(vg.dtype), vg)

    o_slc = lax.map(sel_block, jnp.arange(nq)).transpose(1, 0, 2, 3, 4, 5).reshape(B, T, H, dh)

    kwp = jnp.pad(kw, ((0, 0), (WINDOW, 0), (0, 0), (0, 0)))
    vwp = jnp.pad(vw, ((0, 0), (WINDOW, 0), (0, 0), (0, 0)))
    kw_len = WINDOW + Q_BLOCK

    def win_block(c):
        t0 = c * Q_BLOCK
        qc = lax.dynamic_slice_in_dim(qg, t0, Q_BLOCK, axis=1)
        kc_ = lax.dynamic_slice_in_dim(kwp, t0, kw_len, axis=1)
        vc_ = lax.dynamic_slice_in_dim(vwp, t0, kw_len, axis=1)
        tq = t0 + jnp.arange(Q_BLOCK)
        kp = t0 - WINDOW + jnp.arange(kw_len)
        d = tq[:, None] - kp[None, :]
        mask = (d >= 0) & (d < WINDOW) & (kp >= 0)[None, :]
        bb = bias_tab[t5_bucket(d)].reshape(Q_BLOCK, kw_len, G, HPG).transpose(2, 3, 0, 1)
        sc = jnp.einsum('bqghd,bkgd->bghqk', qc, kc_) * scale + bb
        pp = masked_softmax(sc, mask)
        return jnp.einsum('bghqk,bkgd->bqghd', pp.astype(vc_.dtype), vc_)

    o_win = lax.map(win_block, jnp.arange(nq)).transpose(1, 0, 2, 3, 4, 5).reshape(B, T, H, dh)

    o = gates[..., 0:1] * o_cmp + gates[..., 1:2] * o_slc + gates[..., 2:3] * o_win
    return o.reshape(B, T, H * dh)


def diff_attention(q, k, v, bias_tab, lam, lam_init, subln_g):
    B, T, H, _, dq = q.shape
    scale = dq ** -0.5
    nq = T // Q_BLOCK
    kpos = jnp.arange(T)

    def blk(c):
        t0 = c * Q_BLOCK
        qc = lax.dynamic_slice_in_dim(q, t0, Q_BLOCK, axis=1)
        tq = t0 + jnp.arange(Q_BLOCK)
        d = tq[:, None] - kpos[None, :]
        bb = bias_tab[t5_bucket(d)].transpose(2, 0, 1)[:, None]
        s = jnp.einsum('bqhcd,bkhcd->bhcqk', qc, k) * scale + bb
        p = masked_softmax(s, d >= 0)
        a = p[:, :, 0] - lam * p[:, :, 1]
        return jnp.einsum('bhqk,bkhd->bqhd', a.astype(v.dtype), v)

    o = lax.map(blk, jnp.arange(nq)).transpose(1, 0, 2, 3, 4).reshape(B, T, H, -1)
    of = o.astype(jnp.float32)
    of = of * lax.rsqrt(jnp.mean(jnp.square(of), -1, keepdims=True) + LN_EPS) * subln_g * (1.0 - lam_init)
    return of.astype(q.dtype).reshape(B, T, H * of.shape[-1])


def hybrid_attention(x, w_in, w_out, rel_bias, cmp_pos, cmp_w1, cmp_w2, lam_q1, lam_k1, lam_q2, lam_k2, subln_g, layer_idx):
    B, T, _ = x.shape
    G = NSA_GROUPS
    (nq_, kc, vc, ks, vs, kw, vw, gt, dq_, dk_, dv_) = _split(x @ w_in, A_SPLITS)
    rg = lambda a: a.reshape(B, T, G, NSA_DIM)
    o_nsa = nsa_attention(nq_.reshape(B, T, NSA_HEADS, NSA_DIM), rg(kc), rg(vc), rg(ks), rg(vs), rg(kw), rg(vw),
                          jax.nn.sigmoid(gt.reshape(B, T, NSA_HEADS, 3)), rel_bias[:, :NSA_HEADS],
                          cmp_pos[0], cmp_w1[0], cmp_w2[0], cmp_pos[1], cmp_w1[1], cmp_w2[1])
    lam_init = 0.8 - 0.6 * math.exp(-0.3 * layer_idx)
    f32 = jnp.float32
    lam = (jnp.exp(jnp.sum(lam_q1.astype(f32) * lam_k1.astype(f32)))
           - jnp.exp(jnp.sum(lam_q2.astype(f32) * lam_k2.astype(f32))) + lam_init)
    o_diff = diff_attention(dq_.reshape(B, T, DIFF_HEADS, 2, DIFF_QK), dk_.reshape(B, T, DIFF_HEADS, 2, DIFF_QK),
                            dv_.reshape(B, T, DIFF_HEADS, DIFF_V), rel_bias[:, NSA_HEADS:], lam, lam_init, subln_g)
    return jnp.concatenate([o_nsa, o_diff], axis=-1) @ w_out


def rotary(x):
    T, d = x.shape[1], x.shape[-1]
    inv = ROPE_BASE ** (-jnp.arange(0, d, 2, dtype=jnp.float32) / d)
    ang = jnp.arange(T, dtype=jnp.float32)[:, None] * inv[None, :]
    cos = jnp.cos(ang)[None, :, None, :]
    sin = jnp.sin(ang)[None, :, None, :]
    x1, x2 = jnp.split(x.astype(jnp.float32), 2, axis=-1)
    return jnp.concatenate([x1 * cos - x2 * sin, x1 * sin + x2 * cos], axis=-1)


def retention_block(x, w_in, w_out):
    B, T, _ = x.shape
    H, dk, dv, C = RET_HEADS, RET_QK, RET_V, RET_CHUNK
    f32 = jnp.float32
    q, k, v, g = _split(x @ w_in, RET_SPLITS)
    q = rotary(q.reshape(B, T, H, dk))
    k = rotary(k.reshape(B, T, H, dk)) * dk ** -0.5
    v = v.reshape(B, T, H, dv).astype(f32)
    log_gamma = jnp.log(1.0 - 2.0 ** (-5.0 - jnp.arange(H, dtype=f32)))
    i = jnp.arange(C, dtype=f32)
    rel = i[:, None] - i[None, :]
    decay = jnp.where(rel >= 0, jnp.exp(jnp.maximum(rel, 0.0)[None] * log_gamma[:, None, None]), 0.0)
    q_decay = jnp.exp((i + 1.0)[None, :] * log_gamma[:, None])
    k_decay = jnp.exp((C - 1.0 - i)[None, :] * log_gamma[:, None])
    chunk_decay = jnp.exp(C * log_gamma)
    n = T // C

    def to_chunks(a):
        return a.reshape(B, n, C, H, a.shape[-1]).transpose(1, 0, 3, 2, 4)

    def step(state, inp):
        qc, kc, vc = inp
        inner = jnp.einsum('bhij,bhje->bhie', jnp.einsum('bhid,bhjd->bhij', qc, kc) * decay, vc)
        cross = jnp.einsum('bhid,bhde->bhie', qc, state) * q_decay[..., None]
        state = state * chunk_decay[:, None, None] + jnp.einsum('bhjd,bhje->bhde', kc * k_decay[..., None], vc)
        return state, inner + cross

    s0 = jnp.zeros((B, H, dk, dv), f32)
    _, y = lax.scan(step, s0, (to_chunks(q), to_chunks(k), to_chunks(v)))
    y = y.transpose(1, 0, 3, 2, 4).reshape(B, T, H, dv)
    mu = jnp.mean(y, -1, keepdims=True)
    var = jnp.mean(jnp.square(y - mu), -1, keepdims=True)
    y = (y - mu) * lax.rsqrt(var + LN_EPS)
    out = jax.nn.silu(g.astype(f32)) * y.reshape(B, T, H * dv)
    return out.astype(x.dtype) @ w_out


def setup_inputs(seed: int = 0) -> dict:
    key = jax.random.key(seed)
    ks = jax.random.split(key, 18)
    f32 = jnp.float32
    nrm = lambda k, shape, s: jax.random.normal(k, shape, f32) * s
    return {
        "x": nrm(ks[0], (BATCH, SEQ, D_MODEL), 1.0),
        "ffn_w_in": nrm(ks[1], (DEPTH, 2, D_MODEL, 2 * D_FF), D_MODEL ** -0.5),
        "ffn_w_out": nrm(ks[2], (DEPTH, 2, D_FF, D_MODEL), D_FF ** -0.5 * BETA),
        "ln_gain": 1.0 + nrm(ks[3], (DEPTH, 3, D_MODEL), 0.02),
        "ln_bias": nrm(ks[4], (DEPTH, 3, D_MODEL), 0.02),
        "rel_bias": nrm(ks[5], (NUM_BUCKETS, ATT_HEADS), 0.2),
        "a_w_in": nrm(ks[6], (N_EVEN, D_MODEL, A_WIDTH), D_MODEL ** -0.5),
        "a_w_out": nrm(ks[7], (N_EVEN, MIX_A_OUT, D_MODEL), MIX_A_OUT ** -0.5 * BETA),
        "nsa_cmp_pos": nrm(ks[8], (N_EVEN, 2, CMP_LEN, NSA_DIM), 0.02),
        "nsa_cmp_w1": nrm(ks[9], (N_EVEN, 2, CMP_LEN * NSA_DIM, NSA_DIM), (CMP_LEN * NSA_DIM) ** -0.5),
        "nsa_cmp_w2": nrm(ks[10], (N_EVEN, 2, NSA_DIM, NSA_DIM), NSA_DIM ** -0.5),
        "diff_lam_q1": nrm(ks[11], (N_EVEN, DIFF_QK), 0.1),
        "diff_lam_k1": nrm(ks[12], (N_EVEN, DIFF_QK), 0.1),
        "diff_lam_q2": nrm(ks[13], (N_EVEN, DIFF_QK), 0.1),
        "diff_lam_k2": nrm(ks[14], (N_EVEN, DIFF_QK), 0.1),
        "diff_subln": 1.0 + nrm(ks[15], (N_EVEN, DIFF_V), 0.02),
        "ret_w_in": nrm(ks[16], (N_ODD, D_MODEL, RET_WIDTH), D_MODEL ** -0.5),
        "ret_w_out": nrm(ks[17], (N_ODD, RET_HEADS * RET_V, D_MODEL), (RET_HEADS * RET_V) ** -0.5 * BETA),
    }


def reference(x, ffn_w_in, ffn_w_out, ln_gain, ln_bias, rel_bias, a_w_in, a_w_out, nsa_cmp_pos, nsa_cmp_w1,
              nsa_cmp_w2, diff_lam_q1, diff_lam_k1, diff_lam_q2, diff_lam_k2, diff_subln, ret_w_in, ret_w_out):
    for li in range(DEPTH):
        g, b = ln_gain[li], ln_bias[li]
        x = layer_norm(ALPHA * x + 0.5 * swiglu(x, ffn_w_in[li, 0], ffn_w_out[li, 0]), g[0], b[0])
        if li % 2 == 0:
            e = li // 2
            mix = hybrid_attention(x, a_w_in[e], a_w_out[e], rel_bias, nsa_cmp_pos[e], nsa_cmp_w1[e], nsa_cmp_w2[e],
                                   diff_lam_q1[e], diff_lam_k1[e], diff_lam_q2[e], diff_lam_k2[e], diff_subln[e], li)
        else:
            o = li // 2
            mix = retention_block(x, ret_w_in[o], ret_w_out[o])
        x = layer_norm(ALPHA * x + mix, g[1], b[1])
        x = layer_norm(ALPHA * x + 0.5 * swiglu(x, ffn_w_in[li, 1], ffn_w_out[li, 1]), g[2], b[2])
    return x
```

```cpp
#include <hip/hip_runtime.h>
#include <hip/hip_cooperative_groups.h>
#include <cstdio>
#include <cstdint>
namespace cg = cooperative_groups;
namespace pg8 {
#define PG8_LAS __attribute__((address_space(3)))
typedef unsigned short bf16_t;
typedef short bf16x8 __attribute__((ext_vector_type(8)));
typedef float f32x4 __attribute__((ext_vector_type(4)));
typedef unsigned u32x4 __attribute__((ext_vector_type(4)));
constexpr int BM = 256, BK = 64, HALF = 128, HTB = HALF * BK * 2  , STAGE_BYTES = 8 * HTB, NXCD = 8, WGM = 8;

__host__ __device__ __forceinline__ int lds_byte(int r, int c) { const int st = (r >> 4) * 2 + (c >> 5), rr = r & 15, cc = c & 31, ob = rr * 64 + cc * 2; return st * 1024 + (ob ^ (((ob >> 9) & 1) << 5)); }
__host__ __device__ __forceinline__ void stage_rc(int b, int& R, int& C) { const int st = b / 1024, sb = b % 1024, swz = sb ^ (((sb >> 9) & 1) << 5); R = (st >> 1) * 16 + swz / 64; C = (st & 1) * 32 + (swz % 64) / 2; }
__host__ __device__ __forceinline__ int perm32(int rho) { const int n = rho >> 4, i = rho & 15; return 8 * (i >> 2) + 4 * n + (i & 3); }

struct Unit { int pm, pn; };
struct Gemm { const bf16_t* A; const bf16_t* Bt; int M, N, K; };

struct StaticOrder {
    int nM, nN, nwg, G, c;
    __host__ __device__ void init(int M, int N, int G_, int c_) { nM = M / BM; nN = N / BM; nwg = nM * nN; G = G_; c = c_; }
    __host__ __device__ bool next(int i, Unit& u) const {
        const long L = (long)i * G + c; if (L >= nwg) return false;
        int wgid = (int)L; { const int q = nwg / NXCD, r = nwg % NXCD, xcd = wgid % NXCD, off = wgid / NXCD; wgid = (xcd < r ? xcd * (q + 1) : r * (q + 1) + (xcd - r) * q) + off; }
        const int nig = WGM * nN, gid = wgid / nig, fm = gid * WGM, gsz = (nM - fm) < WGM ? (nM - fm) : WGM;
        u.pm = fm + ((wgid % nig) % gsz); u.pn = (wgid % nig) / gsz; return true;
    }
    __device__ __forceinline__ void a_ready(const Unit&) const {}
    __device__ __forceinline__ void done(const Unit&) const {}
};

__device__ __forceinline__ unsigned cvt_pk_bf16(float lo, float hi) { unsigned r; asm volatile("v_cvt_pk_bf16_f32 %0, %1, %2" : "=v"(r) : "v"(lo), "v"(hi)); return r; }
__device__ __forceinline__ float silu_f(float x) { return x * __builtin_amdgcn_rcpf(1.0f + __expf(-x)); }
__device__ __forceinline__ u32x4 pack8(const f32x4 v0, const f32x4 v1) { u32x4 w; w.x = cvt_pk_bf16(v0[0], v0[1]); w.y = cvt_pk_bf16(v0[2], v0[3]); w.z = cvt_pk_bf16(v1[0], v1[1]); w.w = cvt_pk_bf16(v1[2], v1[3]); return w; }

struct EpiPlain {
    static constexpr bool PERM = true, AFTER_DRAIN = false;
    bf16_t* O; int ldc;
    __device__ __forceinline__ void operator()(const f32x4 (&acc)[2][2][4][2], const Unit& u, int wr, int wc, int fr, int fq) const {
        const int row0 = u.pm * BM + wr * 64 + fr, col0 = u.pn * BM + wc * 32 + 8 * fq;
#pragma unroll
        for (int ai = 0; ai < 2; ++ai)
#pragma unroll
            for (int m = 0; m < 4; ++m) { bf16_t* rowp = O + (size_t)(row0 + ai * HALF + m * 16) * ldc + col0;
#pragma unroll
                for (int bj = 0; bj < 2; ++bj) *(u32x4*)(rowp + bj * HALF) = pack8(acc[ai][bj][m][0], acc[ai][bj][m][1]); }
    }
};
struct EpiSwiGLU {
    static constexpr bool PERM = true, AFTER_DRAIN = false;
    bf16_t* H; int ldh;
    __device__ __forceinline__ void operator()(const f32x4 (&acc)[2][2][4][2], const Unit& u, int wr, int wc, int fr, int fq) const {
        const int row0 = u.pm * BM + wr * 64 + fr, col0 = u.pn * HALF + wc * 32 + 8 * fq;
#pragma unroll
        for (int ai = 0; ai < 2; ++ai)
#pragma unroll
            for (int m = 0; m < 4; ++m) {
                f32x4 h0, h1;
#pragma unroll
                for (int j = 0; j < 4; ++j) { h0[j] = silu_f(acc[ai][0][m][0][j]) * acc[ai][1][m][0][j]; h1[j] = silu_f(acc[ai][0][m][1][j]) * acc[ai][1][m][1][j]; }
                *(u32x4*)(H + (size_t)(row0 + ai * HALF + m * 16) * ldh + col0) = pack8(h0, h1); }
    }
};
struct EpiResid {
    static constexpr bool PERM = false, AFTER_DRAIN = false;
    float* Y; const float* R; int ldc; float alpha, sc;
    __device__ __forceinline__ void operator()(const f32x4 (&acc)[2][2][4][2], const Unit& u, int wr, int wc, int fr, int fq) const {
        const int row0 = u.pm * BM + wr * 64 + fr, col0 = u.pn * BM + wc * 32 + 4 * fq;
#pragma unroll
        for (int ai = 0; ai < 2; ++ai)
#pragma unroll
            for (int m = 0; m < 4; ++m) { const size_t ro = (size_t)(row0 + ai * HALF + m * 16) * ldc + col0;
#pragma unroll
                for (int bj = 0; bj < 2; ++bj)
#pragma unroll
                    for (int n = 0; n < 2; ++n) { const f32x4 r = *(const f32x4*)(R + ro + bj * HALF + n * 16); *(f32x4*)(Y + ro + bj * HALF + n * 16) = r * alpha + acc[ai][bj][m][n] * sc; } }
    }
};
struct EpiRet {
    static constexpr bool PERM = true, AFTER_DRAIN = false;
    bf16_t* O; int ldc; const float* cs; const float* sn; int T;
    __device__ __forceinline__ void operator()(const f32x4 (&acc)[2][2][4][2], const Unit& u, int wr, int wc, int fr, int fq) const {
        const int row0 = u.pm * BM + wr * 64 + fr, d0 = wc * 32 + 8 * fq, col0 = u.pn * BM + d0;
        const int kind = u.pn < 8 ? 0 : (u.pn < 16 ? 1 : (u.pn < 32 ? 2 : 3));
#pragma unroll
        for (int ai = 0; ai < 2; ++ai)
#pragma unroll
            for (int m = 0; m < 4; ++m) { const int row = row0 + ai * HALF + m * 16; bf16_t* rowp = O + (size_t)row * ldc + col0;
                if (kind <= 1) {
                    const int t = row & (T - 1); const float ks = kind == 1 ? 0.0625f : 1.0f;
                    f32x4 o1[2], o2[2];
#pragma unroll
                    for (int n = 0; n < 2; ++n) { const f32x4 c = *(const f32x4*)(cs + (size_t)t * 128 + d0 + 4 * n), s = *(const f32x4*)(sn + (size_t)t * 128 + d0 + 4 * n);
                        const f32x4 x1 = acc[ai][0][m][n], x2 = acc[ai][1][m][n]; o1[n] = (x1 * c - x2 * s) * ks; o2[n] = (x1 * s + x2 * c) * ks; }
                    *(u32x4*)(rowp) = pack8(o1[0], o1[1]); *(u32x4*)(rowp + HALF) = pack8(o2[0], o2[1]);
                } else if (kind == 2) {
#pragma unroll
                    for (int bj = 0; bj < 2; ++bj) *(u32x4*)(rowp + bj * HALF) = pack8(acc[ai][bj][m][0], acc[ai][bj][m][1]);
                } else {
#pragma unroll
                    for (int bj = 0; bj < 2; ++bj) { f32x4 a, b;
#pragma unroll
                        for (int j = 0; j < 4; ++j) { a[j] = silu_f(acc[ai][bj][m][0][j]); b[j] = silu_f(acc[ai][bj][m][1][j]); }
                        *(u32x4*)(rowp + bj * HALF) = pack8(a, b); }
                } }
    }
};

template <class Epi, class Sched, bool ALIGN_EPI = false, bool SP2 = false>
__device__ __forceinline__ void gemm_phase(PG8_LAS unsigned char* lds, const Gemm g, const Sched& S, const Epi& E) {
    int tid_l = threadIdx.x; asm volatile("" : "+v"(tid_l));
    const int tid = tid_l, wid = __builtin_amdgcn_readfirstlane(tid >> 6), lane = tid & 63, wr = wid >> 2, wc = wid & 3, fr = lane & 15, fq = lane >> 4;
    const int K = g.K, nt = K / BK;
    unsigned voffA[2], voffB[2];
#pragma unroll
    for (int i = 0; i < 2; ++i) { int R, C; stage_rc(tid * 16 + i * 8192, R, C); const int Rb = Epi::PERM ? ((R & ~31) + perm32(R & 31)) : R;
        voffA[i] = (unsigned)(R * K + C) * 2u; voffB[i] = (unsigned)(Rb * K + C) * 2u; }
    const size_t kstep = (size_t)(BK * 2);
    const size_t hstep = (size_t)HALF * K * 2;
    const size_t tstep = 2 * hstep;
    const unsigned ldsw = (unsigned)wid * 1024u;
    const int aoff = lds_byte(wr * 64 + fr, fq * 8), boff = lds_byte(wc * 32 + fr, fq * 8);
#define PG8_SA(b, h) (((b) * 2 + (h)) * HTB)
#define PG8_SB(b, h) ((4 + (b) * 2 + (h)) * HTB)
#define PG8_STAGE(bufoff, gbase, voff) do { _Pragma("unroll") for (int _i = 0; _i < 2; ++_i) \
        __builtin_amdgcn_global_load_lds((const unsigned*)((const char*)(gbase) + (voff)[_i]), (PG8_LAS unsigned*)(lds + (bufoff) + ldsw + _i * 8192), 16, 0, 0); } while (0)
#define PG8_LDA(dst, b, h) do { _Pragma("unroll") for (int m = 0; m < 4; ++m) _Pragma("unroll") for (int k = 0; k < 2; ++k) dst[m][k] = *(const PG8_LAS bf16x8*)(lds + PG8_SA(b, h) + aoff + m * 2048 + k * 1024); } while (0)
#define PG8_LDB(dst, b, h) do { _Pragma("unroll") for (int n = 0; n < 2; ++n) _Pragma("unroll") for (int k = 0; k < 2; ++k) dst[n][k] = *(const PG8_LAS bf16x8*)(lds + PG8_SB(b, h) + boff + n * 2048 + k * 1024); } while (0)
#define PG8_MMA(ai, bj, At, Bt) do { __builtin_amdgcn_s_setprio(1); _Pragma("unroll") for (int m = 0; m < 4; ++m) _Pragma("unroll") for (int n = 0; n < 2; ++n) _Pragma("unroll") for (int k = 0; k < 2; ++k) \
        acc[ai][bj][m][n] = __builtin_amdgcn_mfma_f32_16x16x32_bf16(Bt[n][k], At[m][k], acc[ai][bj][m][n], 0, 0, 0); __builtin_amdgcn_s_setprio(0); } while (0)
#define PG8_WAIT_V(n) asm volatile("s_waitcnt vmcnt(" #n ")" ::: "memory")
#define PG8_WAIT_L(n) asm volatile("s_waitcnt lgkmcnt(" #n ")" ::: "memory")
#define PG8_BAR __builtin_amdgcn_s_barrier()
#define PG8_SCHED __builtin_amdgcn_sched_barrier(0)
    Unit cur, nxt; int ui = 0;
    if (!S.next(0, cur)) return;
    f32x4 acc[2][2][4][2];
#pragma unroll
    for (int a = 0; a < 2; ++a)
#pragma unroll
        for (int b = 0; b < 2; ++b)
#pragma unroll
            for (int m = 0; m < 4; ++m)
#pragma unroll
                for (int n = 0; n < 2; ++n) acc[a][b][m][n] = (f32x4){0.f, 0.f, 0.f, 0.f};
    bf16x8 At[4][2], B0[2][2], B1[2][2];
    const char* cA = (const char*)g.A + (size_t)cur.pm * tstep; const char* cB = (const char*)g.Bt + (size_t)cur.pn * tstep;
    S.a_ready(cur);
    if constexpr (SP2) {
        PG8_STAGE(PG8_SB(0, 0), cB, voffB); PG8_STAGE(PG8_SB(0, 1), cB + hstep, voffB); PG8_STAGE(PG8_SA(0, 0), cA, voffA); PG8_STAGE(PG8_SA(0, 1), cA + hstep, voffA);
        if (wr == 1) PG8_BAR;
        PG8_WAIT_V(2); PG8_BAR;
        PG8_STAGE(PG8_SB(1, 0), cB + kstep, voffB); PG8_STAGE(PG8_SA(1, 0), cA + kstep, voffA); PG8_STAGE(PG8_SB(1, 1), cB + hstep + kstep, voffB);
        PG8_WAIT_V(6); PG8_BAR;
    } else {
        PG8_STAGE(PG8_SB(0, 0), cB, voffB); PG8_STAGE(PG8_SA(0, 0), cA, voffA); PG8_STAGE(PG8_SB(0, 1), cB + hstep, voffB); PG8_STAGE(PG8_SA(0, 1), cA + hstep, voffA);
        if (wr == 1) PG8_BAR;
        PG8_WAIT_V(4); PG8_BAR;
        PG8_STAGE(PG8_SB(1, 0), cB + kstep, voffB); PG8_STAGE(PG8_SA(1, 0), cA + kstep, voffA); PG8_STAGE(PG8_SB(1, 1), cB + hstep + kstep, voffB);
        PG8_WAIT_V(6); PG8_BAR;
    }
    for (;;) {
        const bool has_next = S.next(ui + 1, nxt);
        const char* nA = has_next ? (const char*)g.A + (size_t)nxt.pm * tstep : cA; const char* nB = has_next ? (const char*)g.Bt + (size_t)nxt.pn * tstep : cB;
        for (int t = 0; t < nt; t += 2) {
            const bool last = (t == nt - 2);
            const char* a1 = cA + (size_t)(t + 1) * kstep;
            const char* a2 = last ? nA : cA + (size_t)(t + 2) * kstep; const char* b2 = last ? nB : cB + (size_t)(t + 2) * kstep;
            const char* a3 = a2 + kstep; const char* b3 = b2 + kstep;
            if (last && has_next) S.a_ready(nxt);
            if constexpr (SP2) {
            PG8_LDB(B0, 0, 0); PG8_LDB(B1, 0, 1); PG8_SCHED; PG8_LDA(At, 0, 0); PG8_STAGE(PG8_SA(1, 1), a1 + hstep, voffA);
            PG8_WAIT_V(8); PG8_WAIT_L(0); PG8_BAR; PG8_MMA(0, 0, At, B0); PG8_MMA(0, 1, At, B1); PG8_BAR; PG8_SCHED;
            PG8_LDA(At, 0, 1); PG8_STAGE(PG8_SB(0, 0), b2, voffB); PG8_STAGE(PG8_SB(0, 1), b2 + hstep, voffB); PG8_STAGE(PG8_SA(0, 0), a2, voffA);
            PG8_WAIT_V(8); PG8_WAIT_L(0); PG8_BAR; PG8_MMA(1, 0, At, B0); PG8_MMA(1, 1, At, B1); PG8_BAR; PG8_SCHED;
            PG8_LDB(B0, 1, 0); PG8_LDB(B1, 1, 1); PG8_SCHED; PG8_LDA(At, 1, 0); PG8_STAGE(PG8_SA(0, 1), a2 + hstep, voffA);
            PG8_WAIT_V(8); PG8_WAIT_L(0); PG8_BAR; PG8_MMA(0, 0, At, B0); PG8_MMA(0, 1, At, B1); PG8_BAR; PG8_SCHED;
            PG8_LDA(At, 1, 1); PG8_STAGE(PG8_SB(1, 0), b3, voffB); PG8_STAGE(PG8_SB(1, 1), b3 + hstep, voffB); PG8_STAGE(PG8_SA(1, 0), a3, voffA);
            PG8_WAIT_V(8); PG8_WAIT_L(0); PG8_BAR; PG8_MMA(1, 0, At, B0); PG8_MMA(1, 1, At, B1); PG8_BAR; PG8_SCHED;
            } else {
            PG8_LDB(B0, 0, 0); PG8_SCHED; PG8_LDA(At, 0, 0); PG8_STAGE(PG8_SA(1, 1), a1 + hstep, voffA);
            PG8_WAIT_L(8); PG8_BAR; PG8_WAIT_L(0); PG8_MMA(0, 0, At, B0); PG8_BAR; PG8_SCHED;
            PG8_LDB(B1, 0, 1); PG8_STAGE(PG8_SB(0, 0), b2, voffB);
            PG8_BAR; PG8_WAIT_L(0); PG8_MMA(0, 1, At, B1); PG8_BAR;
            PG8_LDA(At, 0, 1); PG8_STAGE(PG8_SA(0, 0), a2, voffA);
            PG8_BAR; PG8_WAIT_L(0); PG8_MMA(1, 0, At, B0); PG8_BAR; PG8_SCHED;
            PG8_STAGE(PG8_SB(0, 1), b2 + hstep, voffB);
            PG8_WAIT_V(6); PG8_BAR; PG8_MMA(1, 1, At, B1); PG8_BAR;
            PG8_LDB(B0, 1, 0); PG8_SCHED; PG8_LDA(At, 1, 0); PG8_STAGE(PG8_SA(0, 1), a2 + hstep, voffA);
            PG8_WAIT_L(8); PG8_BAR; PG8_WAIT_L(0); PG8_MMA(0, 0, At, B0); PG8_BAR; PG8_SCHED;
            PG8_LDB(B1, 1, 1); PG8_STAGE(PG8_SB(1, 0), b3, voffB);
            PG8_BAR; PG8_WAIT_L(0); PG8_MMA(0, 1, At, B1); PG8_BAR;
            PG8_LDA(At, 1, 1); PG8_STAGE(PG8_SA(1, 0), a3, voffA);
            PG8_BAR; PG8_WAIT_L(0); PG8_MMA(1, 0, At, B0); PG8_BAR; PG8_SCHED;
            PG8_STAGE(PG8_SB(1, 1), b3 + hstep, voffB);
            PG8_WAIT_V(6); PG8_BAR; PG8_MMA(1, 1, At, B1); PG8_BAR;
            }
        }
        if constexpr (ALIGN_EPI) { if (wr == 0) PG8_BAR; }
        if constexpr (!Epi::AFTER_DRAIN) { E(acc, cur, wr, wc, fr, fq); S.done(cur); }
        if (!has_next) break;
#pragma unroll
        for (int a = 0; a < 2; ++a)
#pragma unroll
            for (int b = 0; b < 2; ++b)
#pragma unroll
                for (int m = 0; m < 4; ++m)
#pragma unroll
                    for (int n = 0; n < 2; ++n) acc[a][b][m][n] = (f32x4){0.f, 0.f, 0.f, 0.f};
        cur = nxt; cA = nA; cB = nB; ++ui;
        if constexpr (ALIGN_EPI) { if (wr == 1) PG8_BAR; }
    }
    PG8_WAIT_V(0);
    if constexpr (!ALIGN_EPI) { if (wr == 0) PG8_BAR; }
    PG8_BAR;
    if constexpr (Epi::AFTER_DRAIN) { E.fused(acc, cur, wr, wc, fr, fq, lds, wid, lane); S.done(cur); }
#undef PG8_SA
#undef PG8_SB
#undef PG8_STAGE
#undef PG8_LDA
#undef PG8_LDB
#undef PG8_MMA
#undef PG8_WAIT_V
#undef PG8_WAIT_L
#undef PG8_BAR
#undef PG8_SCHED
}
}

constexpr int NWAVES = 8, NTHR = 512;
constexpr int BATCH = 4, T = 2048, M = BATCH * T, D = 2048, FF = 5632;
constexpr int APW = 5888;
constexpr int RPW = 12288;
constexpr int AC_Q = 0, AC_KC = 1024, AC_VC = 1280, AC_KS = 1536, AC_VS = 1792, AC_KW = 2048, AC_VW = 2304, AC_DQ = 2560, AC_DK = 3584, AC_DV = 4608, AC_GT = 5632;
constexpr float LN_EPS = 1e-5f, NEGF = -1e30f;
constexpr float ALPHA = 1.41421356237309515f;
constexpr size_t MiB = 1u << 20;
constexpr size_t WS_WFI = 0;
constexpr size_t WS_WFO = WS_WFI + 176 * MiB;
constexpr size_t WS_WAI = WS_WFO + 88 * MiB;
constexpr size_t WS_WAO = WS_WAI + 23 * MiB;
constexpr size_t WS_WRI = WS_WAO + 8 * MiB;
constexpr size_t WS_WRO = WS_WRI + 48 * MiB;
constexpr size_t WS_W1T = WS_WRO + 16 * MiB;
constexpr size_t WS_W2T = WS_W1T + 2 * MiB;
constexpr size_t WS_ROPE = WS_W2T + 1 * MiB;
constexpr size_t WS_XB = WS_ROPE + 2 * MiB;
constexpr size_t WS_XF = WS_XB + 32 * MiB;
constexpr size_t WS_Y = WS_XF + 64 * MiB;
constexpr size_t WS_H = WS_Y + 64 * MiB;
constexpr size_t WS_AP = WS_H + 88 * MiB;
constexpr size_t WS_RP = WS_AP + 92 * MiB;
constexpr size_t WS_OB = WS_RP + 192 * MiB;
constexpr size_t WS_CMP = WS_OB + 64 * MiB;
constexpr size_t WS_END = WS_CMP + 1 * MiB;
constexpr int LDS_BYTES = 147456;

#define LAS __attribute__((address_space(3)))
typedef unsigned short bf16_t;
typedef short bf16x8 __attribute__((ext_vector_type(8)));
typedef short s16x4 __attribute__((ext_vector_type(4)));
typedef float f32x4 __attribute__((ext_vector_type(4)));
typedef unsigned u32x4 __attribute__((ext_vector_type(4)));
typedef unsigned u32x2 __attribute__((ext_vector_type(2)));
typedef LAS unsigned char* ldsp;
#define LDS_WAIT() asm volatile("s_waitcnt lgkmcnt(0)" ::: "memory")
using pg8::cvt_pk_bf16;

__device__ __forceinline__ float wave_sum(float v) {
#pragma unroll
    for (int o = 1; o < 64; o <<= 1) v += __shfl_xor(v, o);
    return v;
}
__device__ __forceinline__ float bf2f(bf16_t b) { return __uint_as_float(((unsigned)b) << 16); }
__device__ __forceinline__ bf16x8 pack_bf8(const f32x4 a, const f32x4 b) { return __builtin_bit_cast(bf16x8, pg8::pack8(a, b)); }

__device__ const unsigned char T5B[116] = {0, 1, 2, 3, 4, 5, 6, 7, 8, 9, 10, 11, 12, 13, 14, 15, 16, 16, 16, 17, 17, 18, 18, 18, 19, 19, 19, 20, 20, 20, 20, 21, 21, 21, 21, 22, 22, 22, 22, 22, 23, 23, 23, 23, 23, 23,
    24, 24, 24, 24, 24, 24, 25, 25, 25, 25, 25, 25, 25, 26, 26, 26, 26, 26, 26, 26, 26, 27, 27, 27, 27, 27, 27, 27, 27, 27, 27, 28, 28, 28, 28, 28, 28, 28, 28, 28, 28, 29, 29, 29, 29, 29, 29, 29, 29, 29, 29, 29, 29,
    30, 30, 30, 30, 30, 30, 30, 30, 30, 30, 30, 30, 30, 30, 31, 31, 31};
constexpr int BT_N = 132;
__device__ __forceinline__ void fill_btab(LAS float* btab, const float* rel_bias, int head0, int nh, int tid) {
    for (int e = tid; e < nh * 129; e += NTHR) { const int h = e / 129, i = e % 129; const int bk = i < 113 ? (int)T5B[i] : 31; btab[h * BT_N + i] = rel_bias[bk * 16 + head0 + h]; }
}

__device__ __forceinline__ int map_row(int mode, int n) {
    if (mode == 1) { const int up = n >= FF, j = up ? n - FF : n; return 256 * (j >> 7) + (up ? 128 : 0) + (j & 127); }
    if (mode == 2) { return n < 2560 ? n : (n < 2584 ? AC_GT + (n - 2560) : n - 24); }
    return n;
}
__device__ __forceinline__ void transpose_item(const float* W, int K, int N, bf16_t* WT, int mode, LAS float* scr, int item, int lane) {
    const int nblk = (N + 63) >> 6, kb = item / nblk, nb = item - kb * nblk, k0 = 64 * kb, n0 = 64 * nb;
    const int c4 = 4 * (lane & 15);
#pragma unroll 4
    for (int i = 0; i < 16; ++i) { const int r = 4 * i + (lane >> 4);
        f32x4 v = {0.f, 0.f, 0.f, 0.f};
        if (n0 + c4 + 3 < N) v = *(const f32x4*)(W + (size_t)(k0 + r) * N + n0 + c4);
        LAS float* s = scr + r * 65 + c4; s[0] = v.x; s[1] = v.y; s[2] = v.z; s[3] = v.w; }
    LDS_WAIT();
    const int c = lane & 7;
#pragma unroll
    for (int j = 0; j < 8; ++j) { const int n = (lane >> 3) + 8 * j; const LAS float* s = scr + (8 * c) * 65 + n;
        u32x4 o; o.x = cvt_pk_bf16(s[0], s[65]); o.y = cvt_pk_bf16(s[130], s[195]); o.z = cvt_pk_bf16(s[260], s[325]); o.w = cvt_pk_bf16(s[390], s[455]);
        if (n0 + n < N) *(u32x4*)(WT + (size_t)map_row(mode, n0 + n) * K + k0 + 8 * c) = o; }
    LDS_WAIT();
}
__device__ __forceinline__ void transpose_mat(const float* W, int K, int N, bf16_t* WT, int mode, LAS float* scr, int gw, int ngw, int lane) {
    const int nitems = (K >> 6) * ((N + 63) >> 6);
    for (int it = gw; it < nitems; it += ngw) transpose_item(W, K, N, WT, mode, scr, it, lane);
}

__device__ __forceinline__ void ln_phase(const float* Y, const float* gain, const float* bias, float* xf, bf16_t* xb, int gw, int ngw, int lane) {
    f32x4 g[8], bb[8];
#pragma unroll
    for (int j = 0; j < 8; ++j) { g[j] = *(const f32x4*)(gain + 4 * lane + 256 * j); bb[j] = *(const f32x4*)(bias + 4 * lane + 256 * j); }
    for (int row = gw; row < M; row += ngw) {
        const float* yr = Y + (size_t)row * D + 4 * lane;
        f32x4 v[8]; float s = 0.f;
#pragma unroll
        for (int j = 0; j < 8; ++j) { v[j] = *(const f32x4*)(yr + 256 * j); s += (v[j].x + v[j].y) + (v[j].z + v[j].w); }
        const float mean = wave_sum(s) * (1.f / D); float s2 = 0.f;
#pragma unroll
        for (int j = 0; j < 8; ++j) { v[j] = v[j] - mean; s2 += (v[j].x * v[j].x + v[j].y * v[j].y) + (v[j].z * v[j].z + v[j].w * v[j].w); }
        const float rstd = __builtin_amdgcn_rsqf(wave_sum(s2) * (1.f / D) + LN_EPS);
#pragma unroll
        for (int j = 0; j < 8; ++j) { const f32x4 o = v[j] * rstd * g[j] + bb[j];
            *(f32x4*)(xf + (size_t)row * D + 4 * lane + 256 * j) = o;
            if (xb) { u32x2 w; w.x = cvt_pk_bf16(o.x, o.y); w.y = cvt_pk_bf16(o.z, o.w); *(u32x2*)(xb + (size_t)row * D + 4 * lane + 256 * j) = w; } }
    }
}

template <int ROWS, int ROWBYTES>
__device__ __forceinline__ void stage_rows(ldsp dst, int dstride, const bf16_t* src, size_t pitch, int tid) {
    constexpr int CPR = ROWBYTES / 16, TOT = ROWS * CPR, IT = TOT / NTHR, U = IT < 4 ? IT : 4;
    static_assert(TOT % NTHR == 0 && IT % U == 0, "stage_rows geometry");
#pragma unroll 1
    for (int i0 = 0; i0 < IT; i0 += U) {
        u32x4 v[U];
#pragma unroll
        for (int u = 0; u < U; ++u) { const int idx = tid + (i0 + u) * NTHR, r = idx / CPR, c = idx - r * CPR; v[u] = *(const u32x4*)(src + (size_t)r * pitch + c * 8); }
#pragma unroll
        for (int u = 0; u < U; ++u) { const int idx = tid + (i0 + u) * NTHR, r = idx / CPR, c = idx - r * CPR; *(LAS u32x4*)(dst + r * dstride + c * 16) = v[u]; }
    }
}
template <int NKS>
__device__ __forceinline__ void qk_tile(f32x4 (&st)[4], ldsp Ksh, int kstride, const bf16x8* qf, int fr, int g) {
#pragma unroll
    for (int a = 0; a < 4; ++a) { st[a] = (f32x4){0.f, 0.f, 0.f, 0.f};
        ldsp kp = Ksh + (32 * (a >> 1) + 8 * (fr >> 2) + 4 * (a & 1) + (fr & 3)) * kstride + 16 * g;
#pragma unroll
        for (int ks = 0; ks < NKS; ++ks) { const bf16x8 kf = *(const LAS bf16x8*)(kp + 64 * ks); st[a] = __builtin_amdgcn_mfma_f32_16x16x32_bf16(kf, qf[ks], st[a], 0, 0, 0); } }
}
typedef short v4i16_t __attribute__((ext_vector_type(4)));
__device__ __forceinline__ s16x4 vtr(ldsp p) { return __builtin_bit_cast(s16x4, __builtin_amdgcn_ds_read_tr16_b64_v4i16((LAS v4i16_t*)p)); }
template <int NB>
__device__ __forceinline__ void pv_tile(f32x4* ot, ldsp Vsh, int vstride, const bf16x8 pf0, const bf16x8 pf1, int lane) {
    const int g = lane >> 4, q = (lane & 15) >> 2, p = lane & 3;
    ldsp vb = Vsh + (8 * g + q) * vstride + 8 * p;
#pragma unroll
    for (int nb = 0; nb < NB; ++nb) {
#pragma unroll
        for (int c = 0; c < 2; ++c) { ldsp a = vb + 32 * c * vstride + 32 * nb; const s16x4 lo = vtr(a), hi = vtr(a + 4 * vstride);
            const bf16x8 vf = (bf16x8){lo[0], lo[1], lo[2], lo[3], hi[0], hi[1], hi[2], hi[3]};
            ot[nb] = __builtin_amdgcn_mfma_f32_16x16x32_bf16(vf, c ? pf1 : pf0, ot[nb], 0, 0, 0); } }
}
template <int NB>
__device__ __forceinline__ void softmax_step(f32x4 (&st)[4], float& m, float& l, f32x4* ot, bf16x8& pf0, bf16x8& pf1) {
    float mx = fmaxf(fmaxf(fmaxf(st[0][0], st[0][1]), fmaxf(st[0][2], st[0][3])), fmaxf(fmaxf(st[1][0], st[1][1]), fmaxf(st[1][2], st[1][3])));
    mx = fmaxf(mx, fmaxf(fmaxf(fmaxf(st[2][0], st[2][1]), fmaxf(st[2][2], st[2][3])), fmaxf(fmaxf(st[3][0], st[3][1]), fmaxf(st[3][2], st[3][3]))));
    mx = fmaxf(mx, __shfl_xor(mx, 16)); mx = fmaxf(mx, __shfl_xor(mx, 32));
    const float mn = fmaxf(m, mx), al = __expf(m - mn); m = mn;
    float s = 0.f;
#pragma unroll
    for (int a = 0; a < 4; ++a)
#pragma unroll
        for (int j = 0; j < 4; ++j) { st[a][j] = __expf(st[a][j] - mn); s += st[a][j]; }
    l = l * al + s;
#pragma unroll
    for (int nb = 0; nb < NB; ++nb) ot[nb] = ot[nb] * al;
    pf0 = pack_bf8(st[0], st[1]); pf1 = pack_bf8(st[2], st[3]);
}

__device__ __forceinline__ float gelu_tanh(float x) { const float u = 0.7978845608028654f * (x + 0.044715f * x * x * x); const float e = __expf(2.f * u); const float th = 1.f - 2.f * __builtin_amdgcn_rcpf(e + 1.f); return 0.5f * x * (1.f + th); }
__device__ __forceinline__ void compress_item(int item, const bf16_t* AP, const float* pos_all, const bf16_t* W1T, const bf16_t* W2T, bf16_t* CMP, ldsp lds, int tid, int wave, int lane) {
    const int rb = item & 7, g = (item >> 3) & 1, b = (item >> 4) & 3, kv = item >> 6;
    const int fr = lane & 15, fg = lane >> 4;
    const int c = min(16 * rb + fr, 126);
    const bf16_t* src = AP + (size_t)(b * T + 16 * c) * APW + (kv ? AC_VC : AC_KC) + g * 128;
    const float* pos = pos_all + kv * 32 * 128;
    const bf16_t* w1 = W1T + (size_t)kv * 128 * 4096;
    f32x4 acc[8];
#pragma unroll
    for (int nb = 0; nb < 8; ++nb) acc[nb] = (f32x4){0.f, 0.f, 0.f, 0.f};
    for (int ks = 0; ks < 16; ++ks) {
        const int l = 4 * wave + (ks >> 2), d = 32 * (ks & 3) + 8 * fg, k = 128 * l + d;
        const u32x4 raw = *(const u32x4*)(src + (size_t)l * APW + d);
        const f32x4 p0 = *(const f32x4*)(pos + l * 128 + d), p1 = *(const f32x4*)(pos + l * 128 + d + 4);
        f32x4 a0, a1;
        a0[0] = __uint_as_float(raw.x << 16) + p0[0]; a0[1] = __uint_as_float(raw.x & 0xffff0000u) + p0[1]; a0[2] = __uint_as_float(raw.y << 16) + p0[2]; a0[3] = __uint_as_float(raw.y & 0xffff0000u) + p0[3];
        a1[0] = __uint_as_float(raw.z << 16) + p1[0]; a1[1] = __uint_as_float(raw.z & 0xffff0000u) + p1[1]; a1[2] = __uint_as_float(raw.w << 16) + p1[2]; a1[3] = __uint_as_float(raw.w & 0xffff0000u) + p1[3];
        const bf16x8 af = pack_bf8(a0, a1);
#pragma unroll
        for (int nb = 0; nb < 8; ++nb) { const bf16x8 bfv = *(const bf16x8*)(w1 + (size_t)(16 * nb + fr) * 4096 + k); acc[nb] = __builtin_amdgcn_mfma_f32_16x16x32_bf16(af, bfv, acc[nb], 0, 0, 0); }
    }
    LAS float* red = (LAS float*)lds;
#pragma unroll
    for (int nb = 0; nb < 8; ++nb)
#pragma unroll
        for (int j = 0; j < 4; ++j) red[wave * 2048 + (4 * fg + j) * 128 + 16 * nb + fr] = acc[nb][j];
    __syncthreads();
    LAS bf16_t* hid = (LAS bf16_t*)(lds + 65536);
#pragma unroll
    for (int i = 0; i < 4; ++i) { const int e = tid + i * NTHR; float s = 0.f;
#pragma unroll
        for (int w = 0; w < 8; ++w) s += red[w * 2048 + e];
        const float h = gelu_tanh(s); hid[(e >> 7) * 136 + (e & 127)] = (bf16_t)(cvt_pk_bf16(h, 0.f) & 0xffffu); }
    __syncthreads();
    const bf16_t* w2 = W2T + (size_t)kv * 128 * 128;
    f32x4 o = (f32x4){0.f, 0.f, 0.f, 0.f};
#pragma unroll
    for (int ks = 0; ks < 4; ++ks) { const bf16x8 af = *(const LAS bf16x8*)((ldsp)hid + (fr * 136 + 32 * ks + 8 * fg) * 2);
        const bf16x8 bfv = *(const bf16x8*)(w2 + (size_t)(16 * wave + fr) * 128 + 32 * ks + 8 * fg); o = __builtin_amdgcn_mfma_f32_16x16x32_bf16(af, bfv, o, 0, 0, 0); }
    bf16_t* dst = CMP + ((size_t)((kv * 4 + b) * 2 + g) * 128) * 128;
#pragma unroll
    for (int j = 0; j < 4; ++j) { const int cc = 16 * rb + 4 * fg + j; const float v = cc <= 126 ? o[j] : 0.f; dst[(size_t)cc * 128 + 16 * wave + fr] = (bf16_t)(cvt_pk_bf16(v, 0.f) & 0xffffu); }
    __syncthreads();
}

constexpr int DKS = 272, DVS = 288;
__device__ __forceinline__ void diff_item(int b, int h, int qb, const bf16_t* AP, bf16_t* OB, const float* subln, float lam, ldsp lds, int tid, int wave, int lane) {
    const int fr = lane & 15, g = lane >> 4;
    ldsp Ksh = lds, Vsh = lds + 64 * DKS;
    const LAS float* btab = (const LAS float*)(lds + 64 * DKS + 64 * DVS) + h * BT_N;
    const int t0 = 128 * qb, tq = t0 + 16 * wave + fr;
    const bf16_t* qrow = AP + (size_t)(b * T + tq) * APW + AC_DQ + h * 128;
    bf16x8 qf[2][2];
#pragma unroll
    for (int c = 0; c < 2; ++c)
#pragma unroll
        for (int ks = 0; ks < 2; ++ks) qf[c][ks] = *(const bf16x8*)(qrow + c * 64 + 32 * ks + 8 * g);
    f32x4 ot[2][8];
#pragma unroll
    for (int c = 0; c < 2; ++c)
#pragma unroll
        for (int nb = 0; nb < 8; ++nb) ot[c][nb] = (f32x4){0.f, 0.f, 0.f, 0.f};
    float m[2] = {NEGF, NEGF}, l[2] = {0.f, 0.f};
    const int ntile = 2 * qb + 2, tqmax = t0 + 16 * wave + 15;
    for (int kt = 0; kt < ntile; ++kt) {
        __syncthreads();
        stage_rows<64, 256>(Ksh, DKS, AP + (size_t)(b * T + 64 * kt) * APW + AC_DK + h * 128, APW, tid);
        stage_rows<64, 256>(Vsh, DVS, AP + (size_t)(b * T + 64 * kt) * APW + AC_DV + h * 128, APW, tid);
        __syncthreads();
        if (64 * kt > tqmax) continue;
        bf16x8 pf[2][2];
#pragma unroll
        for (int c = 0; c < 2; ++c) {
            f32x4 st[4];
            qk_tile<2>(st, Ksh + 128 * c, DKS, qf[c], fr, g);
#pragma unroll
            for (int a = 0; a < 4; ++a)
#pragma unroll
                for (int j = 0; j < 4; ++j) { const int kpos = 64 * kt + 32 * (a >> 1) + 8 * g + 4 * (a & 1) + j, d = tq - kpos;
                    st[a][j] = d >= 0 ? st[a][j] * 0.125f + btab[min(d, 128)] : NEGF; }
            softmax_step<8>(st, m[c], l[c], ot[c], pf[c][0], pf[c][1]);
        }
        { const int q = (lane & 15) >> 2, p = lane & 3; ldsp vb = Vsh + (8 * g + q) * DVS + 8 * p;
#pragma unroll
          for (int nb = 0; nb < 8; ++nb)
#pragma unroll
            for (int c2 = 0; c2 < 2; ++c2) { ldsp a = vb + 32 * c2 * DVS + 32 * nb; const s16x4 lo = vtr(a), hi = vtr(a + 4 * DVS);
                const bf16x8 vf = (bf16x8){lo[0], lo[1], lo[2], lo[3], hi[0], hi[1], hi[2], hi[3]};
                ot[0][nb] = __builtin_amdgcn_mfma_f32_16x16x32_bf16(vf, pf[0][c2], ot[0][nb], 0, 0, 0);
                ot[1][nb] = __builtin_amdgcn_mfma_f32_16x16x32_bf16(vf, pf[1][c2], ot[1][nb], 0, 0, 0); } }
    }
    float l0 = l[0], l1 = l[1];
    l0 += __shfl_xor(l0, 16); l0 += __shfl_xor(l0, 32); l1 += __shfl_xor(l1, 16); l1 += __shfl_xor(l1, 32);
    const float r0 = 1.f / l0, r1 = lam / l1;
    float ss = 0.f;
#pragma unroll
    for (int nb = 0; nb < 8; ++nb) { ot[0][nb] = ot[0][nb] * r0 - ot[1][nb] * r1; ss += (ot[0][nb][0] * ot[0][nb][0] + ot[0][nb][1] * ot[0][nb][1]) + (ot[0][nb][2] * ot[0][nb][2] + ot[0][nb][3] * ot[0][nb][3]); }
    ss += __shfl_xor(ss, 16); ss += __shfl_xor(ss, 32);
    const float rn = __builtin_amdgcn_rsqf(ss * (1.f / 128.f) + LN_EPS) * 0.8f;
    bf16_t* orow = OB + (size_t)(b * T + tq) * D + 1024 + h * 128;
#pragma unroll
    for (int nb = 0; nb < 8; ++nb) { const f32x4 sg = *(const f32x4*)(subln + 16 * nb + 4 * g); const f32x4 o = ot[0][nb] * rn * sg;
        u32x2 w; w.x = cvt_pk_bf16(o[0], o[1]); w.y = cvt_pk_bf16(o[2], o[3]); *(u32x2*)(orow + 16 * nb + 4 * g) = w; }
}

constexpr int NS_K = 0, NS_V = 128 * DKS, NS_BT = NS_V + 128 * DVS, NS_IM = NS_BT + 8 * BT_N * 4, NS_IH = NS_IM + 16384, NS_IF = NS_IH + 16384, NS_SM = NS_IF + 4096, NS_END = NS_SM + 128;
static_assert(NS_END <= 131072, "nsa lds");
template <int MODE  >
__device__ __forceinline__ void nsa_stream_tile(int kt0, int tq, unsigned selbit_ok, ldsp Ksh, ldsp Vsh, const LAS float* bt, const bf16x8* qf, float& m, float& l, f32x4* ot, int fr, int g, int lane) {
    f32x4 st[4];
    qk_tile<4>(st, Ksh, DKS, qf, fr, g);
#pragma unroll
    for (int a = 0; a < 4; ++a)
#pragma unroll
        for (int j = 0; j < 4; ++j) { const int kpos = kt0 + 32 * (a >> 1) + 8 * g + 4 * (a & 1) + j, d = tq - kpos;
            const bool ok = MODE == 1 ? (d >= 0 && selbit_ok) : (d >= 0 && d < 512);
            st[a][j] = ok ? st[a][j] * 0.08838834764831845f + bt[min(max(d, 0), 128)] : NEGF; }
    bf16x8 pf0, pf1;
    softmax_step<8>(st, m, l, ot, pf0, pf1);
    pv_tile<8>(ot, Vsh, DVS, pf0, pf1, lane);
}
__device__ __forceinline__ void nsa_item(int b, int grp, int qt, const bf16_t* AP, const bf16_t* CMP, bf16_t* OB, ldsp lds, int tid, int wave, int lane) {
    const int fr = lane & 15, g = lane >> 4, hh = wave >> 1, qs = wave & 1;
    ldsp Ksh = lds + NS_K, Vsh = lds + NS_V;
    const LAS float* bt = (const LAS float*)(lds + NS_BT) + (grp * 4 + hh) * BT_N;
    LAS float* impM = (LAS float*)(lds + NS_IM); LAS float* impH = (LAS float*)(lds + NS_IH); LAS float* impF = (LAS float*)(lds + NS_IF);
    LAS unsigned* selm = (LAS unsigned*)(lds + NS_SM);
    const int t0 = 32 * qt, ql = 16 * qs + fr, tq = t0 + ql, head = grp * 4 + hh, tblk = t0 >> 6;
    const size_t rowq = (size_t)(b * T + tq) * APW;
    bf16x8 qf[4];
#pragma unroll
    for (int ks = 0; ks < 4; ++ks) qf[ks] = *(const bf16x8*)(AP + rowq + AC_Q + head * 128 + 32 * ks + 8 * g);
    float gate[3];
#pragma unroll
    for (int r = 0; r < 3; ++r) { const float x = bf2f(AP[rowq + AC_GT + head * 3 + r]); gate[r] = __builtin_amdgcn_rcpf(1.f + __expf(-x)); }
    f32x4 res[8], ot[8];
    __syncthreads();
    stage_rows<128, 256>(Ksh, DKS, CMP + (size_t)((0 * 4 + b) * 2 + grp) * 128 * 128, 128, tid);
    stage_rows<128, 256>(Vsh, DVS, CMP + (size_t)((1 * 4 + b) * 2 + grp) * 128 * 128, 128, tid);
    __syncthreads();
    {
        f32x4 s0[4], s1[4];
        qk_tile<4>(s0, Ksh, DKS, qf, fr, g); qk_tile<4>(s1, Ksh + 64 * DKS, DKS, qf, fr, g);
        float mx = NEGF;
#pragma unroll
        for (int a = 0; a < 4; ++a)
#pragma unroll
            for (int j = 0; j < 4; ++j) { const int c0 = 32 * (a >> 1) + 8 * g + 4 * (a & 1) + j, c1 = c0 + 64; const int d0 = tq - (16 * c0 + 31), d1 = tq - (16 * c1 + 31);
                s0[a][j] = d0 >= 0 ? s0[a][j] * 0.08838834764831845f + bt[min(d0, 128)] : NEGF; s1[a][j] = d1 >= 0 ? s1[a][j] * 0.08838834764831845f + bt[min(d1, 128)] : NEGF;
                mx = fmaxf(mx, fmaxf(s0[a][j], s1[a][j])); }
        mx = fmaxf(mx, __shfl_xor(mx, 16)); mx = fmaxf(mx, __shfl_xor(mx, 32));
        float sum = 0.f;
#pragma unroll
        for (int a = 0; a < 4; ++a)
#pragma unroll
            for (int j = 0; j < 4; ++j) { s0[a][j] = __expf(s0[a][j] - mx); s1[a][j] = __expf(s1[a][j] - mx); sum += s0[a][j] + s1[a][j]; }
        sum += __shfl_xor(sum, 16); sum += __shfl_xor(sum, 32);
        const float inv = tq >= 31 ? 1.f / sum : 0.f;
#pragma unroll
        for (int a = 0; a < 4; ++a) { s0[a] = s0[a] * inv; s1[a] = s1[a] * inv; }
#pragma unroll
        for (int a = 0; a < 4; ++a) { const int J = 8 * (a >> 1) + 2 * g + (a & 1);
            impM[(hh * 32 + ql) * 32 + J] = (s0[a][0] + s0[a][1]) + (s0[a][2] + 0.5f * s0[a][3]); impH[(hh * 32 + ql) * 32 + J] = 0.5f * s0[a][3];
            impM[(hh * 32 + ql) * 32 + J + 16] = (s1[a][0] + s1[a][1]) + (s1[a][2] + 0.5f * s1[a][3]); impH[(hh * 32 + ql) * 32 + J + 16] = 0.5f * s1[a][3]; }
#pragma unroll
        for (int nb = 0; nb < 8; ++nb) ot[nb] = (f32x4){0.f, 0.f, 0.f, 0.f};
        pv_tile<8>(ot, Vsh, DVS, pack_bf8(s0[0], s0[1]), pack_bf8(s0[2], s0[3]), lane);
        pv_tile<8>(ot, Vsh + 64 * DVS, DVS, pack_bf8(s1[0], s1[1]), pack_bf8(s1[2], s1[3]), lane);
#pragma unroll
        for (int nb = 0; nb < 8; ++nb) res[nb] = ot[nb] * gate[0];
    }
    __syncthreads();
#pragma unroll
    for (int i = 0; i < 2; ++i) { const int e = tid + i * NTHR, q = e >> 5, J = e & 31; float s = 0.f;
#pragma unroll
        for (int h4 = 0; h4 < 4; ++h4) { s += impM[(h4 * 32 + q) * 32 + J]; if (J > 0) s += impH[(h4 * 32 + q) * 32 + J - 1]; }
        impF[q * 32 + J] = s; }
    __syncthreads();
    if (tid < 32) {
        unsigned chosen = 0u;
        for (int r = 0; r < 8; ++r) { float best = -1.f; int bi = -1;
            for (int j = 0; j <= tblk; ++j) { if ((chosen >> j) & 1u) continue; const float v = (j == 0 || j == tblk || j == tblk - 1) ? __builtin_inff() : impF[tid * 32 + j]; if (v > best) { best = v; bi = j; } }
            if (bi >= 0) chosen |= 1u << bi; }
        selm[tid] = chosen;
    }
    __syncthreads();
    unsigned uni = 0u;
#pragma unroll 8
    for (int q = 0; q < 32; ++q) uni |= selm[q];
    const unsigned mysel = selm[ql];
    {
        float m = NEGF, l = 0.f;
#pragma unroll
        for (int nb = 0; nb < 8; ++nb) ot[nb] = (f32x4){0.f, 0.f, 0.f, 0.f};
        for (int j = 0; j <= tblk; ++j) {
            if (!((uni >> j) & 1u)) continue;
            __syncthreads();
            stage_rows<64, 256>(Ksh, DKS, AP + (size_t)(b * T + 64 * j) * APW + AC_KS + grp * 128, APW, tid);
            stage_rows<64, 256>(Vsh, DVS, AP + (size_t)(b * T + 64 * j) * APW + AC_VS + grp * 128, APW, tid);
            __syncthreads();
            const unsigned mine = (mysel >> j) & 1u;
            if (__ballot(mine) == 0ull) continue;
            nsa_stream_tile<1>(64 * j, tq, mine, Ksh, Vsh, bt, qf, m, l, ot, fr, g, lane);
        }
        l += __shfl_xor(l, 16); l += __shfl_xor(l, 32);
        const float sc = gate[1] / l;
#pragma unroll
        for (int nb = 0; nb < 8; ++nb) res[nb] = res[nb] + ot[nb] * sc;
    }
    {
        float m = NEGF, l = 0.f;
#pragma unroll
        for (int nb = 0; nb < 8; ++nb) ot[nb] = (f32x4){0.f, 0.f, 0.f, 0.f};
        const int kt_lo = max(0, (t0 - 511) >> 6);
        for (int kt = kt_lo; kt <= tblk; ++kt) {
            __syncthreads();
            stage_rows<64, 256>(Ksh, DKS, AP + (size_t)(b * T + 64 * kt) * APW + AC_KW + grp * 128, APW, tid);
            stage_rows<64, 256>(Vsh, DVS, AP + (size_t)(b * T + 64 * kt) * APW + AC_VW + grp * 128, APW, tid);
            __syncthreads();
            nsa_stream_tile<2>(64 * kt, tq, 1u, Ksh, Vsh, bt, qf, m, l, ot, fr, g, lane);
        }
        l += __shfl_xor(l, 16); l += __shfl_xor(l, 32);
        const float sc = gate[2] / l;
#pragma unroll
        for (int nb = 0; nb < 8; ++nb) res[nb] = res[nb] + ot[nb] * sc;
    }
    bf16_t* orow = OB + (size_t)(b * T + tq) * D + head * 128;
#pragma unroll
    for (int nb = 0; nb < 8; ++nb) { u32x2 w; w.x = cvt_pk_bf16(res[nb][0], res[nb][1]); w.y = cvt_pk_bf16(res[nb][2], res[nb][3]); *(u32x2*)(orow + 16 * nb + 4 * g) = w; }
}

constexpr int RKS = 528, RVS = 1056;
static_assert(64 * RKS + 64 * RVS <= 131072, "ret lds");
__device__ __forceinline__ void ret_item(int b, int h, int qb, const bf16_t* RP, bf16_t* OB, ldsp lds, int tid, int wave, int lane) {
    const int fr = lane & 15, g = lane >> 4;
    ldsp Ksh = lds, Vsh = lds + 64 * RKS;
    const int t0 = 128 * qb, tq = t0 + 16 * wave + fr, tqmax = t0 + 16 * wave + 15;
    const size_t rowq = (size_t)(b * T + tq) * RPW;
    bf16x8 qf[8];
#pragma unroll
    for (int ks = 0; ks < 8; ++ks) qf[ks] = *(const bf16x8*)(RP + rowq + h * 256 + 32 * ks + 8 * g);
    f32x4 ot[32];
#pragma unroll
    for (int nb = 0; nb < 32; ++nb) ot[nb] = (f32x4){0.f, 0.f, 0.f, 0.f};
    const float lg2 = log2f(1.0f - exp2f(-5.0f - (float)h));
    const int ntile = 2 * qb + 2;
    for (int kt = 0; kt < ntile; ++kt) {
        __syncthreads();
        stage_rows<64, 512>(Ksh, RKS, RP + (size_t)(b * T + 64 * kt) * RPW + 2048 + h * 256, RPW, tid);
        stage_rows<64, 1024>(Vsh, RVS, RP + (size_t)(b * T + 64 * kt) * RPW + 4096 + h * 512, RPW, tid);
        __syncthreads();
        if (64 * kt > tqmax) continue;
        f32x4 st[4];
        qk_tile<8>(st, Ksh, RKS, qf, fr, g);
#pragma unroll
        for (int a = 0; a < 4; ++a)
#pragma unroll
            for (int j = 0; j < 4; ++j) { const int kpos = 64 * kt + 32 * (a >> 1) + 8 * g + 4 * (a & 1) + j, d = tq - kpos;
                st[a][j] = d >= 0 ? st[a][j] * exp2f((float)d * lg2) : 0.f; }
        pv_tile<32>(ot, Vsh, RVS, pack_bf8(st[0], st[1]), pack_bf8(st[2], st[3]), lane);
    }
    float s = 0.f;
#pragma unroll
    for (int nb = 0; nb < 32; ++nb) s += (ot[nb][0] + ot[nb][1]) + (ot[nb][2] + ot[nb][3]);
    s += __shfl_xor(s, 16); s += __shfl_xor(s, 32);
    const float mu = s * (1.f / 512.f); float s2 = 0.f;
#pragma unroll
    for (int nb = 0; nb < 32; ++nb) { ot[nb] = ot[nb] - mu; s2 += (ot[nb][0] * ot[nb][0] + ot[nb][1] * ot[nb][1]) + (ot[nb][2] * ot[nb][2] + ot[nb][3] * ot[nb][3]); }
    s2 += __shfl_xor(s2, 16); s2 += __shfl_xor(s2, 32);
    const float rstd = __builtin_amdgcn_rsqf(s2 * (1.f / 512.f) + LN_EPS);
    const bf16_t* grow = RP + rowq + 8192 + h * 512;
    bf16_t* orow = OB + (size_t)(b * T + tq) * 4096 + h * 512;
#pragma unroll
    for (int nb = 0; nb < 32; ++nb) { const u32x2 gr = *(const u32x2*)(grow + 16 * nb + 4 * g);
        const float g0 = __uint_as_float(gr.x << 16), g1 = __uint_as_float(gr.x & 0xffff0000u), g2 = __uint_as_float(gr.y << 16), g3 = __uint_as_float(gr.y & 0xffff0000u);
        u32x2 w; w.x = cvt_pk_bf16(ot[nb][0] * rstd * g0, ot[nb][1] * rstd * g1); w.y = cvt_pk_bf16(ot[nb][2] * rstd * g2, ot[nb][3] * rstd * g3); *(u32x2*)(orow + 16 * nb + 4 * g) = w; }
}

struct Args { const float* in[18]; float* out; unsigned char* ws; };
__global__ void __launch_bounds__(NTHR, 2) fwd_megakernel(Args args) {
    extern __shared__ __attribute__((aligned(16))) unsigned char lds_raw[];
    cg::grid_group grid = cg::this_grid();
    ldsp lds = (ldsp)lds_raw;
    const int G = gridDim.x, bx = blockIdx.x, ngw = G * NWAVES;
#define PHASE_IDS() int tid = threadIdx.x; asm volatile("" : "+v"(tid)); const int lane = tid & 63, wave = __builtin_amdgcn_readfirstlane(tid >> 6), gw = bx * NWAVES + wave; (void)lane; (void)gw;
#define OPQ(p) ({ auto _p = (p); asm volatile("" : "+s"(_p)); _p; })
#define WSP(TY, off) ((TY*)(OPQ(args.ws) + (off)))
#define INP(i) ((const float*)OPQ(args.in[i]))
#define x_in INP(0)
#define ffn_w_in INP(1)
#define ffn_w_out INP(2)
#define ln_gain INP(3)
#define ln_bias INP(4)
#define rel_bias INP(5)
#define a_w_in INP(6)
#define a_w_out INP(7)
#define cmp_pos INP(8)
#define cmp_w1 INP(9)
#define cmp_w2 INP(10)
#define ret_w_in INP(16)
#define ret_w_out INP(17)
#define WFI WSP(bf16_t, WS_WFI)
#define WFO WSP(bf16_t, WS_WFO)
#define WAI WSP(bf16_t, WS_WAI)
#define WAO WSP(bf16_t, WS_WAO)
#define WRI WSP(bf16_t, WS_WRI)
#define WRO WSP(bf16_t, WS_WRO)
#define W1T WSP(bf16_t, WS_W1T)
#define W2T WSP(bf16_t, WS_W2T)
#define ROPE_C WSP(float, WS_ROPE)
#define ROPE_S WSP(float, WS_ROPE + (size_t)T * 128 * 4)
#define XB WSP(bf16_t, WS_XB)
#define XF WSP(float, WS_XF)
#define Y WSP(float, WS_Y)
#define HB WSP(bf16_t, WS_H)
#define AP WSP(bf16_t, WS_AP)
#define RP WSP(bf16_t, WS_RP)
#define OB WSP(bf16_t, WS_OB)
#define CMP WSP(bf16_t, WS_CMP)

    {
        PHASE_IDS();
        LAS float* scr = (LAS float*)(lds + wave * 16640);
        for (int f = 0; f < 4; ++f) {
            transpose_mat(ffn_w_in + (size_t)f * D * 2 * FF, D, 2 * FF, WFI + (size_t)f * 2 * FF * D, 1, scr, gw, ngw, lane);
            transpose_mat(ffn_w_out + (size_t)f * FF * D, FF, D, WFO + (size_t)f * D * FF, 0, scr, gw, ngw, lane);
        }
        transpose_mat(a_w_in, D, 5656, WAI, 2, scr, gw, ngw, lane);
        transpose_mat(a_w_out, D, D, WAO, 0, scr, gw, ngw, lane);
        transpose_mat(ret_w_in, D, RPW, WRI, 0, scr, gw, ngw, lane);
        transpose_mat(ret_w_out, 4096, D, WRO, 0, scr, gw, ngw, lane);
        for (int kv = 0; kv < 2; ++kv) {
            transpose_mat(cmp_w1 + (size_t)kv * 4096 * 128, 4096, 128, W1T + (size_t)kv * 128 * 4096, 0, scr, gw, ngw, lane);
            transpose_mat(cmp_w2 + (size_t)kv * 128 * 128, 128, 128, W2T + (size_t)kv * 128 * 128, 0, scr, gw, ngw, lane);
        }
        const size_t gt = (size_t)bx * NTHR + tid, ngt = (size_t)G * NTHR;
        { bf16_t* wai = WAI; for (size_t i = gt; i < (size_t)(APW - 5656) * D / 8; i += ngt) *(u32x4*)(wai + (size_t)5656 * D + i * 8) = (u32x4){0u, 0u, 0u, 0u}; }
        { const float* xi = x_in; bf16_t* xb = XB; for (size_t i = gt; i < (size_t)M * D / 4; i += ngt) { const f32x4 v = *(const f32x4*)(xi + i * 4); u32x2 w; w.x = cvt_pk_bf16(v.x, v.y); w.y = cvt_pk_bf16(v.z, v.w); *(u32x2*)(xb + i * 4) = w; } }
        float* rc = ROPE_C; float* rs = ROPE_S;
        for (size_t i = gt; i < (size_t)T * 128; i += ngt) { const int t = (int)(i >> 7), j = (int)(i & 127);
            const float inv = powf(10000.0f, -(float)j * (1.0f / 128.0f)); const float ang = (float)t * inv;
            const double rev = (double)ang * 0.15915494309189535; const float frac = (float)(rev - floor(rev));
            rc[i] = __builtin_amdgcn_cosf(frac); rs[i] = __builtin_amdgcn_sinf(frac); }
    }
    grid.sync();

    pg8::StaticOrder S;
    for (int li = 0; li < 2; ++li) {
        for (int sub = 0; sub < 3; ++sub) {
            const bf16_t* rA; const bf16_t* rB; int rK; float rsc;
            if (sub != 1) {
                const int f = li * 2 + (sub == 2 ? 1 : 0);
                { pg8::Gemm gm{XB, WFI + (size_t)f * 2 * FF * D, M, 2 * FF, D}; S.init(M, 2 * FF, G, bx); pg8::EpiSwiGLU E{HB, FF};

#ifndef NO_G1
 pg8::gemm_phase<pg8::EpiSwiGLU, pg8::StaticOrder, true, true>(lds, gm, S, E);
#endif
 }
                grid.sync();
                rA = HB; rB = WFO + (size_t)f * D * FF; rK = FF; rsc = 0.5f;
            } else if (li == 0) {
                { pg8::Gemm gm{XB, WAI, M, APW, D}; S.init(M, APW, G, bx); pg8::EpiPlain E{AP, APW};

#ifndef NO_G2
 pg8::gemm_phase<pg8::EpiPlain, pg8::StaticOrder, true, true>(lds, gm, S, E);
#endif
 }
                grid.sync();
                { PHASE_IDS();
#ifndef NO_CMP
                for (int it = bx; it < 128; it += G) compress_item(it, AP, cmp_pos, W1T, W2T, CMP, lds, tid, wave, lane);
#endif
                {
                    float lam;
                    { const float a = wave_sum(INP(11)[lane] * INP(12)[lane]), c = wave_sum(INP(13)[lane] * INP(14)[lane]); lam = expf(a) - expf(c) + 0.2f; }
                    __syncthreads();
                    fill_btab((LAS float*)(lds + 64 * DKS + 64 * DVS), rel_bias, 8, 8, tid);
                    __syncthreads();
                    for (int it = bx; it < 256; it += G) { const int bh = it >> 3, s8 = it & 7, b = bh >> 3, h = bh & 7;
#ifndef NO_DIFF
                        diff_item(b, h, s8, AP, OB, INP(15), lam, lds + 0, tid, wave, lane);
                        diff_item(b, h, 15 - s8, AP, OB, INP(15), lam, lds + 0, tid, wave, lane);
#endif
                    }
                }
                }
                grid.sync();
                { PHASE_IDS();
                __syncthreads();
                fill_btab((LAS float*)(lds + NS_BT), rel_bias, 0, 8, tid);
                __syncthreads();
                for (int it = bx; it < 256; it += G) { const int bg = it >> 5, s32 = it & 31, b = bg >> 1, grp = bg & 1;
#ifndef NO_NSA
                    nsa_item(b, grp, s32, AP, CMP, OB, lds, tid, wave, lane);
                    nsa_item(b, grp, 63 - s32, AP, CMP, OB, lds, tid, wave, lane);
#endif
                }
                }
                grid.sync();
                rA = OB; rB = WAO; rK = D; rsc = 1.0f;
            } else {
                { pg8::Gemm gm{XB, WRI, M, RPW, D}; S.init(M, RPW, G, bx); pg8::EpiRet E{RP, RPW, ROPE_C, ROPE_S, T};

#ifndef NO_G3
 pg8::gemm_phase<pg8::EpiRet, pg8::StaticOrder, true, true>(lds, gm, S, E);
#endif
 }
                grid.sync();
                { PHASE_IDS();
                for (int it = bx; it < 256; it += G) { const int bh = it >> 3, s8 = it & 7, b = bh >> 3, h = bh & 7;
#ifndef NO_RET
                    ret_item(b, h, s8, RP, OB, lds, tid, wave, lane);
                    ret_item(b, h, 15 - s8, RP, OB, lds, tid, wave, lane);
#endif
                }
                }
                grid.sync();
                rA = OB; rB = WRO; rK = 4096; rsc = 1.0f;
            }
            { pg8::Gemm gm{rA, rB, M, D, rK}; S.init(M, D, G, bx); const float* rres = (li == 0 && sub == 0) ? x_in : (const float*)XF; pg8::EpiResid E{Y, rres, D, ALPHA, rsc};

#ifndef NO_G4
 pg8::gemm_phase<pg8::EpiResid, pg8::StaticOrder, false, true>(lds, gm, S, E);
#endif
 }
            grid.sync();
            const bool last = (li == 1 && sub == 2);
            { PHASE_IDS();
            ln_phase(Y, ln_gain + (size_t)(li * 3 + sub) * D, ln_bias + (size_t)(li * 3 + sub) * D, last ? args.out : (float*)XF, last ? (bf16_t*)nullptr : (bf16_t*)XB, gw, ngw, lane); }
            if (!last) grid.sync();
        }
    }
}

extern "C" void kernel_launch(void* const* d_in, const int* in_sizes, int n_in, void* d_out, int out_size, void* d_ws, size_t ws_size, hipStream_t stream) {
    static int grid = 0;
    if (grid == 0) {
        if (n_in != 18 || out_size != M * D || ws_size < WS_END) { fprintf(stderr, "kernel_launch: unexpected shapes (n_in %d out %d ws %zu)\n", n_in, out_size, ws_size); grid = -1; return; }
        int dev = 0, cus = 0, per_cu = 0;
        hipGetDevice(&dev); hipDeviceGetAttribute(&cus, hipDeviceAttributeMultiprocessorCount, dev);
        if (hipFuncSetAttribute((const void*)fwd_megakernel, hipFuncAttributeMaxDynamicSharedMemorySize, LDS_BYTES) != hipSuccess) { fprintf(stderr, "kernel_launch: hipFuncSetAttribute failed\n"); grid = -1; return; }
        if (hipOccupancyMaxActiveBlocksPerMultiprocessor(&per_cu, (const void*)fwd_megakernel, NTHR, LDS_BYTES) != hipSuccess || per_cu < 1) { fprintf(stderr, "kernel_launch: occupancy query %d\n", per_cu); per_cu = 1; }
        (void)hipGetLastError();
        grid = cus * 1;
        if (grid > 256) grid = 256;
    }
    if (grid < 0) return;
    Args a{};
    for (int i = 0; i < 18; ++i) a.in[i] = (const float*)d_in[i];
    a.out = (float*)d_out; a.ws = (unsigned char*)d_ws;
    void* kargs[] = {&a};
    hipError_t e = hipLaunchCooperativeKernel((const void*)fwd_megakernel, dim3(grid), dim3(NTHR), kargs, LDS_BYTES, stream);
    if (e != hipSuccess) fprintf(stderr, "kernel_launch: cooperative launch failed: %s (grid %d)\n", hipGetErrorString(e), grid);
}
```

```cpp
#include <hip/hip_runtime.h>
#include <hip/hip_cooperative_groups.h>
#include <cstdio>
#include <cstdint>
namespace cg = cooperative_groups;
namespace pg8 {
#define PG8_LAS __attribute__((address_space(3)))
typedef unsigned short bf16_t;
typedef short bf16x8 __attribute__((ext_vector_type(8)));
typedef float f32x4 __attribute__((ext_vector_type(4)));
typedef unsigned u32x4 __attribute__((ext_vector_type(4)));
constexpr int BM = 256, BK = 64, HALF = 128, HTB = HALF * BK * 2  , STAGE_BYTES = 8 * HTB, NXCD = 8, WGM = 8;

__host__ __device__ __forceinline__ int lds_byte(int r, int c) { const int st = (r >> 4) * 2 + (c >> 5), rr = r & 15, cc = c & 31, ob = rr * 64 + cc * 2; return st * 1024 + (ob ^ (((ob >> 9) & 1) << 5)); }
__host__ __device__ __forceinline__ void stage_rc(int b, int& R, int& C) { const int st = b / 1024, sb = b % 1024, swz = sb ^ (((sb >> 9) & 1) << 5); R = (st >> 1) * 16 + swz / 64; C = (st & 1) * 32 + (swz % 64) / 2; }
__host__ __device__ __forceinline__ int perm32(int rho) { const int n = rho >> 4, i = rho & 15; return 8 * (i >> 2) + 4 * n + (i & 3); }

struct Unit { int pm, pn; };
struct Gemm { const bf16_t* A; const bf16_t* Bt; int M, N, K; };

struct StaticOrder {
    int nM, nN, nwg, G, c;
    __host__ __device__ void init(int M, int N, int G_, int c_) { nM = M / BM; nN = N / BM; nwg = nM * nN; G = G_; c = c_; }
    __host__ __device__ bool next(int i, Unit& u) const {
        const long L = (long)i * G + c; if (L >= nwg) return false;
        int wgid = (int)L; { const int q = nwg / NXCD, r = nwg % NXCD, xcd = wgid % NXCD, off = wgid / NXCD; wgid = (xcd < r ? xcd * (q + 1) : r * (q + 1) + (xcd - r) * q) + off; }
        const int nig = WGM * nN, gid = wgid / nig, fm = gid * WGM, gsz = (nM - fm) < WGM ? (nM - fm) : WGM;
        u.pm = fm + ((wgid % nig) % gsz); u.pn = (wgid % nig) / gsz; return true;
    }
    __device__ __forceinline__ void a_ready(const Unit&) const {}
    __device__ __forceinline__ void done(const Unit&) const {}
};

__device__ __forceinline__ unsigned cvt_pk_bf16(float lo, float hi) { unsigned r; asm volatile("v_cvt_pk_bf16_f32 %0, %1, %2" : "=v"(r) : "v"(lo), "v"(hi)); return r; }
__device__ __forceinline__ float silu_f(float x) { return x * __builtin_amdgcn_rcpf(1.0f + __expf(-x)); }
__device__ __forceinline__ u32x4 pack8(const f32x4 v0, const f32x4 v1) { u32x4 w; w.x = cvt_pk_bf16(v0[0], v0[1]); w.y = cvt_pk_bf16(v0[2], v0[3]); w.z = cvt_pk_bf16(v1[0], v1[1]); w.w = cvt_pk_bf16(v1[2], v1[3]); return w; }

struct EpiPlain {
    static constexpr bool PERM = true, AFTER_DRAIN = false;
    bf16_t* O; int ldc;
    __device__ __forceinline__ void operator()(const f32x4 (&acc)[2][2][4][2], const Unit& u, int wr, int wc, int fr, int fq) const {
        const int row0 = u.pm * BM + wr * 64 + fr, col0 = u.pn * BM + wc * 32 + 8 * fq;
#pragma unroll
        for (int ai = 0; ai < 2; ++ai)
#pragma unroll
            for (int m = 0; m < 4; ++m) { bf16_t* rowp = O + (size_t)(row0 + ai * HALF + m * 16) * ldc + col0;
#pragma unroll
                for (int bj = 0; bj < 2; ++bj) *(u32x4*)(rowp + bj * HALF) = pack8(acc[ai][bj][m][0], acc[ai][bj][m][1]); }
    }
};
struct EpiSwiGLU {
    static constexpr bool PERM = true, AFTER_DRAIN = false;
    bf16_t* H; int ldh;
    __device__ __forceinline__ void operator()(const f32x4 (&acc)[2][2][4][2], const Unit& u, int wr, int wc, int fr, int fq) const {
        const int row0 = u.pm * BM + wr * 64 + fr, col0 = u.pn * HALF + wc * 32 + 8 * fq;
#pragma unroll
        for (int ai = 0; ai < 2; ++ai)
#pragma unroll
            for (int m = 0; m < 4; ++m) {
                f32x4 h0, h1;
#pragma unroll
                for (int j = 0; j < 4; ++j) { h0[j] = silu_f(acc[ai][0][m][0][j]) * acc[ai][1][m][0][j]; h1[j] = silu_f(acc[ai][0][m][1][j]) * acc[ai][1][m][1][j]; }
                *(u32x4*)(H + (size_t)(row0 + ai * HALF + m * 16) * ldh + col0) = pack8(h0, h1); }
    }
};
struct EpiResid {
    static constexpr bool PERM = false, AFTER_DRAIN = false;
    float* Y; const float* R; int ldc; float alpha, sc;
    __device__ __forceinline__ void operator()(const f32x4 (&acc)[2][2][4][2], const Unit& u, int wr, int wc, int fr, int fq) const {
        const int row0 = u.pm * BM + wr * 64 + fr, col0 = u.pn * BM + wc * 32 + 4 * fq;
#pragma unroll
        for (int ai = 0; ai < 2; ++ai)
#pragma unroll
            for (int m = 0; m < 4; ++m) { const size_t ro = (size_t)(row0 + ai * HALF + m * 16) * ldc + col0;
#pragma unroll
                for (int bj = 0; bj < 2; ++bj)
#pragma unroll
                    for (int n = 0; n < 2; ++n) { const f32x4 r = *(const f32x4*)(R + ro + bj * HALF + n * 16); *(f32x4*)(Y + ro + bj * HALF + n * 16) = r * alpha + acc[ai][bj][m][n] * sc; } }
    }
};
struct EpiRet {
    static constexpr bool PERM = true, AFTER_DRAIN = false;
    bf16_t* O; int ldc; const float* cs; const float* sn; int T;
    __device__ __forceinline__ void operator()(const f32x4 (&acc)[2][2][4][2], const Unit& u, int wr, int wc, int fr, int fq) const {
        const int row0 = u.pm * BM + wr * 64 + fr, d0 = wc * 32 + 8 * fq, col0 = u.pn * BM + d0;
        const int kind = u.pn < 8 ? 0 : (u.pn < 16 ? 1 : (u.pn < 32 ? 2 : 3));
#pragma unroll
        for (int ai = 0; ai < 2; ++ai)
#pragma unroll
            for (int m = 0; m < 4; ++m) { const int row = row0 + ai * HALF + m * 16; bf16_t* rowp = O + (size_t)row * ldc + col0;
                if (kind <= 1) {
                    const int t = row & (T - 1); const float ks = kind == 1 ? 0.0625f : 1.0f;
                    f32x4 o1[2], o2[2];
#pragma unroll
                    for (int n = 0; n < 2; ++n) { const f32x4 c = *(const f32x4*)(cs + (size_t)t * 128 + d0 + 4 * n), s = *(const f32x4*)(sn + (size_t)t * 128 + d0 + 4 * n);
                        const f32x4 x1 = acc[ai][0][m][n], x2 = acc[ai][1][m][n]; o1[n] = (x1 * c - x2 * s) * ks; o2[n] = (x1 * s + x2 * c) * ks; }
                    *(u32x4*)(rowp) = pack8(o1[0], o1[1]); *(u32x4*)(rowp + HALF) = pack8(o2[0], o2[1]);
                } else if (kind == 2) {
#pragma unroll
                    for (int bj = 0; bj < 2; ++bj) *(u32x4*)(rowp + bj * HALF) = pack8(acc[ai][bj][m][0], acc[ai][bj][m][1]);
                } else {
#pragma unroll
                    for (int bj = 0; bj < 2; ++bj) { f32x4 a, b;
#pragma unroll
                        for (int j = 0; j < 4; ++j) { a[j] = silu_f(acc[ai][bj][m][0][j]); b[j] = silu_f(acc[ai][bj][m][1][j]); }
                        *(u32x4*)(rowp + bj * HALF) = pack8(a, b); }
                } }
    }
};

template <class Epi, class Sched, bool ALIGN_EPI = false, bool SP2 = false>
__device__ __forceinline__ void gemm_phase(PG8_LAS unsigned char* lds, const Gemm g, const Sched& S, const Epi& E) {
    int tid_l = threadIdx.x; asm volatile("" : "+v"(tid_l));
    const int tid = tid_l, wid = __builtin_amdgcn_readfirstlane(tid >> 6), lane = tid & 63, wr = wid >> 2, wc = wid & 3, fr = lane & 15, fq = lane >> 4;
    const int K = g.K, nt = K / BK;
    unsigned voffA[2], voffB[2];
#pragma unroll
    for (int i = 0; i < 2; ++i) { int R, C; stage_rc(tid * 16 + i * 8192, R, C); const int Rb = Epi::PERM ? ((R & ~31) + perm32(R & 31)) : R;
        voffA[i] = (unsigned)(R * K + C) * 2u; voffB[i] = (unsigned)(Rb * K + C) * 2u; }
    const size_t kstep = (size_t)(BK * 2);
    const size_t hstep = (size_t)HALF * K * 2;
    const size_t tstep = 2 * hstep;
    const unsigned ldsw = (unsigned)wid * 1024u;
    const int aoff = lds_byte(wr * 64 + fr, fq * 8), boff = lds_byte(wc * 32 + fr, fq * 8);
#define PG8_SA(b, h) (((b) * 2 + (h)) * HTB)
#define PG8_SB(b, h) ((4 + (b) * 2 + (h)) * HTB)
#define PG8_STAGE(bufoff, gbase, voff) do { _Pragma("unroll") for (int _i = 0; _i < 2; ++_i) \
        __builtin_amdgcn_global_load_lds((const unsigned*)((const char*)(gbase) + (voff)[_i]), (PG8_LAS unsigned*)(lds + (bufoff) + ldsw + _i * 8192), 16, 0, 0); } while (0)
#define PG8_LDA(dst, b, h) do { _Pragma("unroll") for (int m = 0; m < 4; ++m) _Pragma("unroll") for (int k = 0; k < 2; ++k) dst[m][k] = *(const PG8_LAS bf16x8*)(lds + PG8_SA(b, h) + aoff + m * 2048 + k * 1024); } while (0)
#define PG8_LDB(dst, b, h) do { _Pragma("unroll") for (int n = 0; n < 2; ++n) _Pragma("unroll") for (int k = 0; k < 2; ++k) dst[n][k] = *(const PG8_LAS bf16x8*)(lds + PG8_SB(b, h) + boff + n * 2048 + k * 1024); } while (0)
#define PG8_MMA(ai, bj, At, Bt) do { __builtin_amdgcn_s_setprio(1); _Pragma("unroll") for (int m = 0; m < 4; ++m) _Pragma("unroll") for (int n = 0; n < 2; ++n) _Pragma("unroll") for (int k = 0; k < 2; ++k) \
        acc[ai][bj][m][n] = __builtin_amdgcn_mfma_f32_16x16x32_bf16(Bt[n][k], At[m][k], acc[ai][bj][m][n], 0, 0, 0); __builtin_amdgcn_s_setprio(0); } while (0)
#define PG8_WAIT_V(n) asm volatile("s_waitcnt vmcnt(" #n ")" ::: "memory")
#define PG8_WAIT_L(n) asm volatile("s_waitcnt lgkmcnt(" #n ")" ::: "memory")
#define PG8_BAR __builtin_amdgcn_s_barrier()
#define PG8_SCHED __builtin_amdgcn_sched_barrier(0)
    Unit cur, nxt; int ui = 0;
    if (!S.next(0, cur)) return;
    f32x4 acc[2][2][4][2];
#pragma unroll
    for (int a = 0; a < 2; ++a)
#pragma unroll
        for (int b = 0; b < 2; ++b)
#pragma unroll
            for (int m = 0; m < 4; ++m)
#pragma unroll
                for (int n = 0; n < 2; ++n) acc[a][b][m][n] = (f32x4){0.f, 0.f, 0.f, 0.f};
    bf16x8 At[4][2], B0[2][2], B1[2][2];
    const char* cA = (const char*)g.A + (size_t)cur.pm * tstep; const char* cB = (const char*)g.Bt + (size_t)cur.pn * tstep;
    S.a_ready(cur);
    if constexpr (SP2) {
        PG8_STAGE(PG8_SB(0, 0), cB, voffB); PG8_STAGE(PG8_SB(0, 1), cB + hstep, voffB); PG8_STAGE(PG8_SA(0, 0), cA, voffA); PG8_STAGE(PG8_SA(0, 1), cA + hstep, voffA);
        if (wr == 1) PG8_BAR;
        PG8_WAIT_V(2); PG8_BAR;
        PG8_STAGE(PG8_SB(1, 0), cB + kstep, voffB); PG8_STAGE(PG8_SA(1, 0), cA + kstep, voffA); PG8_STAGE(PG8_SB(1, 1), cB + hstep + kstep, voffB);
        PG8_WAIT_V(6); PG8_BAR;
    } else {
        PG8_STAGE(PG8_SB(0, 0), cB, voffB); PG8_STAGE(PG8_SA(0, 0), cA, voffA); PG8_STAGE(PG8_SB(0, 1), cB + hstep, voffB); PG8_STAGE(PG8_SA(0, 1), cA + hstep, voffA);
        if (wr == 1) PG8_BAR;
        PG8_WAIT_V(4); PG8_BAR;
        PG8_STAGE(PG8_SB(1, 0), cB + kstep, voffB); PG8_STAGE(PG8_SA(1, 0), cA + kstep, voffA); PG8_STAGE(PG8_SB(1, 1), cB + hstep + kstep, voffB);
        PG8_WAIT_V(6); PG8_BAR;
    }
    for (;;) {
        const bool has_next = S.next(ui + 1, nxt);
        const char* nA = has_next ? (const char*)g.A + (size_t)nxt.pm * tstep : cA; const char* nB = has_next ? (const char*)g.Bt + (size_t)nxt.pn * tstep : cB;
        for (int t = 0; t < nt; t += 2) {
            const bool last = (t == nt - 2);
            const char* a1 = cA + (size_t)(t + 1) * kstep;
            const char* a2 = last ? nA : cA + (size_t)(t + 2) * kstep; const char* b2 = last ? nB : cB + (size_t)(t + 2) * kstep;
            const char* a3 = a2 + kstep; const char* b3 = b2 + kstep;
            if (last && has_next) S.a_ready(nxt);
            if constexpr (SP2) {
            PG8_LDB(B0, 0, 0); PG8_LDB(B1, 0, 1); PG8_SCHED; PG8_LDA(At, 0, 0); PG8_STAGE(PG8_SA(1, 1), a1 + hstep, voffA);
            PG8_WAIT_V(8); PG8_WAIT_L(0); PG8_BAR; PG8_MMA(0, 0, At, B0); PG8_MMA(0, 1, At, B1); PG8_BAR; PG8_SCHED;
            PG8_LDA(At, 0, 1); PG8_STAGE(PG8_SB(0, 0), b2, voffB); PG8_STAGE(PG8_SB(0, 1), b2 + hstep, voffB); PG8_STAGE(PG8_SA(0, 0), a2, voffA);
            PG8_WAIT_V(8); PG8_WAIT_L(0); PG8_BAR; PG8_MMA(1, 0, At, B0); PG8_MMA(1, 1, At, B1); PG8_BAR; PG8_SCHED;
            PG8_LDB(B0, 1, 0); PG8_LDB(B1, 1, 1); PG8_SCHED; PG8_LDA(At, 1, 0); PG8_STAGE(PG8_SA(0, 1), a2 + hstep, voffA);
            PG8_WAIT_V(8); PG8_WAIT_L(0); PG8_BAR; PG8_MMA(0, 0, At, B0); PG8_MMA(0, 1, At, B1); PG8_BAR; PG8_SCHED;
            PG8_LDA(At, 1, 1); PG8_STAGE(PG8_SB(1, 0), b3, voffB); PG8_STAGE(PG8_SB(1, 1), b3 + hstep, voffB); PG8_STAGE(PG8_SA(1, 0), a3, voffA);
            PG8_WAIT_V(8); PG8_WAIT_L(0); PG8_BAR; PG8_MMA(1, 0, At, B0); PG8_MMA(1, 1, At, B1); PG8_BAR; PG8_SCHED;
            } else {
            PG8_LDB(B0, 0, 0); PG8_SCHED; PG8_LDA(At, 0, 0); PG8_STAGE(PG8_SA(1, 1), a1 + hstep, voffA);
            PG8_WAIT_L(8); PG8_BAR; PG8_WAIT_L(0); PG8_MMA(0, 0, At, B0); PG8_BAR; PG8_SCHED;
            PG8_LDB(B1, 0, 1); PG8_STAGE(PG8_SB(0, 0), b2, voffB);
            PG8_BAR; PG8_WAIT_L(0); PG8_MMA(0, 1, At, B1); PG8_BAR;
            PG8_LDA(At, 0, 1); PG8_STAGE(PG8_SA(0, 0), a2, voffA);
            PG8_BAR; PG8_WAIT_L(0); PG8_MMA(1, 0, At, B0); PG8_BAR; PG8_SCHED;
            PG8_STAGE(PG8_SB(0, 1), b2 + hstep, voffB);
            PG8_WAIT_V(6); PG8_BAR; PG8_MMA(1, 1, At, B1); PG8_BAR;
            PG8_LDB(B0, 1, 0); PG8_SCHED; PG8_LDA(At, 1, 0); PG8_STAGE(PG8_SA(0, 1), a2 + hstep, voffA);
            PG8_WAIT_L(8); PG8_BAR; PG8_WAIT_L(0); PG8_MMA(0, 0, At, B0); PG8_BAR; PG8_SCHED;
            PG8_LDB(B1, 1, 1); PG8_STAGE(PG8_SB(1, 0), b3, voffB);
            PG8_BAR; PG8_WAIT_L(0); PG8_MMA(0, 1, At, B1); PG8_BAR;
            PG8_LDA(At, 1, 1); PG8_STAGE(PG8_SA(1, 0), a3, voffA);
            PG8_BAR; PG8_WAIT_L(0); PG8_MMA(1, 0, At, B0); PG8_BAR; PG8_SCHED;
            PG8_STAGE(PG8_SB(1, 1), b3 + hstep, voffB);
            PG8_WAIT_V(6); PG8_BAR; PG8_MMA(1, 1, At, B1); PG8_BAR;
            }
        }
        if constexpr (ALIGN_EPI) { if (wr == 0) PG8_BAR; }
        if constexpr (!Epi::AFTER_DRAIN) { E(acc, cur, wr, wc, fr, fq); S.done(cur); }
        if (!has_next) break;
#pragma unroll
        for (int a = 0; a < 2; ++a)
#pragma unroll
            for (int b = 0; b < 2; ++b)
#pragma unroll
                for (int m = 0; m < 4; ++m)
#pragma unroll
                    for (int n = 0; n < 2; ++n) acc[a][b][m][n] = (f32x4){0.f, 0.f, 0.f, 0.f};
        cur = nxt; cA = nA; cB = nB; ++ui;
        if constexpr (ALIGN_EPI) { if (wr == 1) PG8_BAR; }
    }
    PG8_WAIT_V(0);
    if constexpr (!ALIGN_EPI) { if (wr == 0) PG8_BAR; }
    PG8_BAR;
    if constexpr (Epi::AFTER_DRAIN) { E.fused(acc, cur, wr, wc, fr, fq, lds, wid, lane); S.done(cur); }
#undef PG8_SA
#undef PG8_SB
#undef PG8_STAGE
#undef PG8_LDA
#undef PG8_LDB
#undef PG8_MMA
#undef PG8_WAIT_V
#undef PG8_WAIT_L
#undef PG8_BAR
#undef PG8_SCHED
}
}

constexpr int NWAVES = 8, NTHR = 512;
constexpr int LDS_BYTES_C = 147456, LDS_BYTES = LDS_BYTES_C;
constexpr int BATCH = 4, T = 2048, M = BATCH * T, D = 2048, FF = 5632;
constexpr int APW = 5888;
constexpr int RPW = 12288;
constexpr int AC_Q = 0, AC_KC = 1024, AC_VC = 1280, AC_KS = 1536, AC_VS = 1792, AC_KW = 2048, AC_VW = 2304, AC_DQ = 2560, AC_DK = 3584, AC_DV = 4608, AC_GT = 5632;
constexpr float LN_EPS = 1e-5f, NEGF = -1e30f;
constexpr float ALPHA = 1.41421356237309515f;
constexpr size_t MiB = 1u << 20;
constexpr size_t WS_WFI = 0;
constexpr size_t WS_WFO = WS_WFI + 176 * MiB;
constexpr size_t WS_WAI = WS_WFO + 88 * MiB;
constexpr size_t WS_WAO = WS_WAI + 23 * MiB;
constexpr size_t WS_WRI = WS_WAO + 8 * MiB;
constexpr size_t WS_WRO = WS_WRI + 48 * MiB;
constexpr size_t WS_W1T = WS_WRO + 16 * MiB;
constexpr size_t WS_W2T = WS_W1T + 2 * MiB;
constexpr size_t WS_ROPE = WS_W2T + 1 * MiB;
constexpr size_t WS_XB = WS_ROPE + 2 * MiB;
constexpr size_t WS_XF = WS_XB + 32 * MiB;
constexpr size_t WS_Y = WS_XF + 64 * MiB;
constexpr size_t WS_H = WS_Y + 64 * MiB;
constexpr size_t WS_AP = WS_H + 88 * MiB;
constexpr size_t WS_RP = WS_AP + 92 * MiB;
constexpr size_t WS_OB = WS_RP + 192 * MiB;
constexpr size_t WS_CMP = WS_OB + 64 * MiB;
constexpr size_t WS_CTL = WS_CMP + 1 * MiB;
constexpr size_t WS_END = WS_CTL + 1 * MiB;
constexpr int MISC_OFF = LDS_BYTES_C - 64;


#define LAS __attribute__((address_space(3)))
typedef unsigned short bf16_t;
typedef short bf16x8 __attribute__((ext_vector_type(8)));
typedef short s16x4 __attribute__((ext_vector_type(4)));
typedef float f32x4 __attribute__((ext_vector_type(4)));
typedef unsigned u32x4 __attribute__((ext_vector_type(4)));
typedef unsigned u32x2 __attribute__((ext_vector_type(2)));
typedef LAS unsigned char* ldsp;
#define LDS_WAIT() asm volatile("s_waitcnt lgkmcnt(0)" ::: "memory")
using pg8::cvt_pk_bf16;

__device__ __forceinline__ float wave_sum(float v) {
#pragma unroll
    for (int o = 1; o < 64; o <<= 1) v += __shfl_xor(v, o);
    return v;
}
__device__ __forceinline__ float bf2f(bf16_t b) { return __uint_as_float(((unsigned)b) << 16); }
__device__ __forceinline__ bf16x8 pack_bf8(const f32x4 a, const f32x4 b) { return __builtin_bit_cast(bf16x8, pg8::pack8(a, b)); }

__device__ const unsigned char T5B[116] = {0, 1, 2, 3, 4, 5, 6, 7, 8, 9, 10, 11, 12, 13, 14, 15, 16, 16, 16, 17, 17, 18, 18, 18, 19, 19, 19, 20, 20, 20, 20, 21, 21, 21, 21, 22, 22, 22, 22, 22, 23, 23, 23, 23, 23, 23,
    24, 24, 24, 24, 24, 24, 25, 25, 25, 25, 25, 25, 25, 26, 26, 26, 26, 26, 26, 26, 26, 27, 27, 27, 27, 27, 27, 27, 27, 27, 27, 28, 28, 28, 28, 28, 28, 28, 28, 28, 28, 29, 29, 29, 29, 29, 29, 29, 29, 29, 29, 29, 29,
    30, 30, 30, 30, 30, 30, 30, 30, 30, 30, 30, 30, 30, 30, 31, 31, 31};
constexpr int BT_N = 132;
__device__ __forceinline__ void fill_btab(LAS float* btab, const float* rel_bias, int head0, int nh, int tid) {
    for (int e = tid; e < nh * 129; e += NTHR) { const int h = e / 129, i = e % 129; const int bk = i < 113 ? (int)T5B[i] : 31; btab[h * BT_N + i] = rel_bias[bk * 16 + head0 + h]; }
}

__device__ __forceinline__ int map_row(int mode, int n) {
    if (mode == 1) { const int up = n >= FF, j = up ? n - FF : n; return 256 * (j >> 7) + (up ? 128 : 0) + (j & 127); }
    if (mode == 2) { return n < 2560 ? n : (n < 2584 ? AC_GT + (n - 2560) : n - 24); }
    return n;
}
__device__ __forceinline__ void transpose_item(const float* W, int K, int N, bf16_t* WT, int mode, LAS float* scr, int item, int lane) {
    const int nblk = (N + 63) >> 6, kb = item / nblk, nb = item - kb * nblk, k0 = 64 * kb, n0 = 64 * nb;
    const int c4 = 4 * (lane & 15);
#pragma unroll 4
    for (int i = 0; i < 16; ++i) { const int r = 4 * i + (lane >> 4);
        f32x4 v = {0.f, 0.f, 0.f, 0.f};
        if (n0 + c4 + 3 < N) v = *(const f32x4*)(W + (size_t)(k0 + r) * N + n0 + c4);
        LAS float* s = scr + r * 65 + c4; s[0] = v.x; s[1] = v.y; s[2] = v.z; s[3] = v.w; }
    LDS_WAIT();
    const int c = lane & 7;
#pragma unroll
    for (int j = 0; j < 8; ++j) { const int n = (lane >> 3) + 8 * j; const LAS float* s = scr + (8 * c) * 65 + n;
        u32x4 o; o.x = cvt_pk_bf16(s[0], s[65]); o.y = cvt_pk_bf16(s[130], s[195]); o.z = cvt_pk_bf16(s[260], s[325]); o.w = cvt_pk_bf16(s[390], s[455]);
        if (n0 + n < N) *(u32x4*)(WT + (size_t)map_row(mode, n0 + n) * K + k0 + 8 * c) = o; }
    LDS_WAIT();
}
__device__ __forceinline__ void transpose_mat(const float* W, int K, int N, bf16_t* WT, int mode, LAS float* scr, int gw, int ngw, int lane) {
    const int nitems = (K >> 6) * ((N + 63) >> 6);
    for (int it = gw; it < nitems; it += ngw) transpose_item(W, K, N, WT, mode, scr, it, lane);
}

__device__ __forceinline__ void ln_phase(const float* Y, const float* gain, const float* bias, float* xf, bf16_t* xb, int gw, int ngw, int lane) {
    f32x4 g[8], bb[8];
#pragma unroll
    for (int j = 0; j < 8; ++j) { g[j] = *(const f32x4*)(gain + 4 * lane + 256 * j); bb[j] = *(const f32x4*)(bias + 4 * lane + 256 * j); }
    for (int row = gw; row < M; row += ngw) {
        const float* yr = Y + (size_t)row * D + 4 * lane;
        f32x4 v[8]; float s = 0.f;
#pragma unroll
        for (int j = 0; j < 8; ++j) { v[j] = *(const f32x4*)(yr + 256 * j); s += (v[j].x + v[j].y) + (v[j].z + v[j].w); }
        const float mean = wave_sum(s) * (1.f / D); float s2 = 0.f;
#pragma unroll
        for (int j = 0; j < 8; ++j) { v[j] = v[j] - mean; s2 += (v[j].x * v[j].x + v[j].y * v[j].y) + (v[j].z * v[j].z + v[j].w * v[j].w); }
        const float rstd = __builtin_amdgcn_rsqf(wave_sum(s2) * (1.f / D) + LN_EPS);
#pragma unroll
        for (int j = 0; j < 8; ++j) { const f32x4 o = v[j] * rstd * g[j] + bb[j];
            *(f32x4*)(xf + (size_t)row * D + 4 * lane + 256 * j) = o;
            if (xb) { u32x2 w; w.x = cvt_pk_bf16(o.x, o.y); w.y = cvt_pk_bf16(o.z, o.w); *(u32x2*)(xb + (size_t)row * D + 4 * lane + 256 * j) = w; } }
    }
}

template <int ROWS, int ROWBYTES>
__device__ __forceinline__ void stage_rows(ldsp dst, int dstride, const bf16_t* src, size_t pitch, int tid) {
    constexpr int CPR = ROWBYTES / 16, TOT = ROWS * CPR, IT = TOT / NTHR, U = IT < 4 ? IT : 4;
    static_assert(TOT % NTHR == 0 && IT % U == 0, "stage_rows geometry");
#pragma unroll 1
    for (int i0 = 0; i0 < IT; i0 += U) {
        u32x4 v[U];
#pragma unroll
        for (int u = 0; u < U; ++u) { const int idx = tid + (i0 + u) * NTHR, r = idx / CPR, c = idx - r * CPR; v[u] = *(const u32x4*)(src + (size_t)r * pitch + c * 8); }
#pragma unroll
        for (int u = 0; u < U; ++u) { const int idx = tid + (i0 + u) * NTHR, r = idx / CPR, c = idx - r * CPR; *(LAS u32x4*)(dst + r * dstride + c * 16) = v[u]; }
    }
}
template <int NKS>
__device__ __forceinline__ void qk_tile(f32x4 (&st)[4], ldsp Ksh, int kstride, const bf16x8* qf, int fr, int g) {
#pragma unroll
    for (int a = 0; a < 4; ++a) { st[a] = (f32x4){0.f, 0.f, 0.f, 0.f};
        ldsp kp = Ksh + (32 * (a >> 1) + 8 * (fr >> 2) + 4 * (a & 1) + (fr & 3)) * kstride + 16 * g;
#pragma unroll
        for (int ks = 0; ks < NKS; ++ks) { const bf16x8 kf = *(const LAS bf16x8*)(kp + 64 * ks); st[a] = __builtin_amdgcn_mfma_f32_16x16x32_bf16(kf, qf[ks], st[a], 0, 0, 0); } }
}
typedef short v4i16_t __attribute__((ext_vector_type(4)));
__device__ __forceinline__ s16x4 vtr(ldsp p) { return __builtin_bit_cast(s16x4, __builtin_amdgcn_ds_read_tr16_b64_v4i16((LAS v4i16_t*)p)); }
template <int NB>
__device__ __forceinline__ void pv_tile(f32x4* ot, ldsp Vsh, int vstride, const bf16x8 pf0, const bf16x8 pf1, int lane) {
    const int g = lane >> 4, q = (lane & 15) >> 2, p = lane & 3;
    ldsp vb = Vsh + (8 * g + q) * vstride + 8 * p;
#pragma unroll
    for (int nb = 0; nb < NB; ++nb) {
#pragma unroll
        for (int c = 0; c < 2; ++c) { ldsp a = vb + 32 * c * vstride + 32 * nb; const s16x4 lo = vtr(a), hi = vtr(a + 4 * vstride);
            const bf16x8 vf = (bf16x8){lo[0], lo[1], lo[2], lo[3], hi[0], hi[1], hi[2], hi[3]};
            ot[nb] = __builtin_amdgcn_mfma_f32_16x16x32_bf16(vf, c ? pf1 : pf0, ot[nb], 0, 0, 0); } }
}
template <int NB>
__device__ __forceinline__ void softmax_step(f32x4 (&st)[4], float& m, float& l, f32x4* ot, bf16x8& pf0, bf16x8& pf1) {
    float mx = fmaxf(fmaxf(fmaxf(st[0][0], st[0][1]), fmaxf(st[0][2], st[0][3])), fmaxf(fmaxf(st[1][0], st[1][1]), fmaxf(st[1][2], st[1][3])));
    mx = fmaxf(mx, fmaxf(fmaxf(fmaxf(st[2][0], st[2][1]), fmaxf(st[2][2], st[2][3])), fmaxf(fmaxf(st[3][0], st[3][1]), fmaxf(st[3][2], st[3][3]))));
    mx = fmaxf(mx, __shfl_xor(mx, 16)); mx = fmaxf(mx, __shfl_xor(mx, 32));
    const float mn = fmaxf(m, mx), al = __expf(m - mn); m = mn;
    float s = 0.f;
#pragma unroll
    for (int a = 0; a < 4; ++a)
#pragma unroll
        for (int j = 0; j < 4; ++j) { st[a][j] = __expf(st[a][j] - mn); s += st[a][j]; }
    l = l * al + s;
#pragma unroll
    for (int nb = 0; nb < NB; ++nb) ot[nb] = ot[nb] * al;
    pf0 = pack_bf8(st[0], st[1]); pf1 = pack_bf8(st[2], st[3]);
}

__device__ __forceinline__ float gelu_tanh(float x) { const float u = 0.7978845608028654f * (x + 0.044715f * x * x * x); const float e = __expf(2.f * u); const float th = 1.f - 2.f * __builtin_amdgcn_rcpf(e + 1.f); return 0.5f * x * (1.f + th); }
__device__ __forceinline__ void compress_item(int item, const bf16_t* AP, const float* pos_all, const bf16_t* W1T, const bf16_t* W2T, bf16_t* CMP, ldsp lds, int tid, int wave, int lane) {
    const int rb = item & 7, g = (item >> 3) & 1, b = (item >> 4) & 3, kv = item >> 6;
    const int fr = lane & 15, fg = lane >> 4;
    const int c = min(16 * rb + fr, 126);
    const bf16_t* src = AP + (size_t)(b * T + 16 * c) * APW + (kv ? AC_VC : AC_KC) + g * 128;
    const float* pos = pos_all + kv * 32 * 128;
    const bf16_t* w1 = W1T + (size_t)kv * 128 * 4096;
    f32x4 acc[8];
#pragma unroll
    for (int nb = 0; nb < 8; ++nb) acc[nb] = (f32x4){0.f, 0.f, 0.f, 0.f};
    for (int ks = 0; ks < 16; ++ks) {
        const int l = 4 * wave + (ks >> 2), d = 32 * (ks & 3) + 8 * fg, k = 128 * l + d;
        const u32x4 raw = *(const u32x4*)(src + (size_t)l * APW + d);
        const f32x4 p0 = *(const f32x4*)(pos + l * 128 + d), p1 = *(const f32x4*)(pos + l * 128 + d + 4);
        f32x4 a0, a1;
        a0[0] = __uint_as_float(raw.x << 16) + p0[0]; a0[1] = __uint_as_float(raw.x & 0xffff0000u) + p0[1]; a0[2] = __uint_as_float(raw.y << 16) + p0[2]; a0[3] = __uint_as_float(raw.y & 0xffff0000u) + p0[3];
        a1[0] = __uint_as_float(raw.z << 16) + p1[0]; a1[1] = __uint_as_float(raw.z & 0xffff0000u) + p1[1]; a1[2] = __uint_as_float(raw.w << 16) + p1[2]; a1[3] = __uint_as_float(raw.w & 0xffff0000u) + p1[3];
        const bf16x8 af = pack_bf8(a0, a1);
#pragma unroll
        for (int nb = 0; nb < 8; ++nb) { const bf16x8 bfv = *(const bf16x8*)(w1 + (size_t)(16 * nb + fr) * 4096 + k); acc[nb] = __builtin_amdgcn_mfma_f32_16x16x32_bf16(af, bfv, acc[nb], 0, 0, 0); }
    }
    LAS float* red = (LAS float*)lds;
#pragma unroll
    for (int nb = 0; nb < 8; ++nb)
#pragma unroll
        for (int j = 0; j < 4; ++j) red[wave * 2048 + (4 * fg + j) * 128 + 16 * nb + fr] = acc[nb][j];
    __syncthreads();
    LAS bf16_t* hid = (LAS bf16_t*)(lds + 65536);
#pragma unroll
    for (int i = 0; i < 4; ++i) { const int e = tid + i * NTHR; float s = 0.f;
#pragma unroll
        for (int w = 0; w < 8; ++w) s += red[w * 2048 + e];
        const float h = gelu_tanh(s); hid[(e >> 7) * 136 + (e & 127)] = (bf16_t)(cvt_pk_bf16(h, 0.f) & 0xffffu); }
    __syncthreads();
    const bf16_t* w2 = W2T + (size_t)kv * 128 * 128;
    f32x4 o = (f32x4){0.f, 0.f, 0.f, 0.f};
#pragma unroll
    for (int ks = 0; ks < 4; ++ks) { const bf16x8 af = *(const LAS bf16x8*)((ldsp)hid + (fr * 136 + 32 * ks + 8 * fg) * 2);
        const bf16x8 bfv = *(const bf16x8*)(w2 + (size_t)(16 * wave + fr) * 128 + 32 * ks + 8 * fg); o = __builtin_amdgcn_mfma_f32_16x16x32_bf16(af, bfv, o, 0, 0, 0); }
    bf16_t* dst = CMP + ((size_t)((kv * 4 + b) * 2 + g) * 128) * 128;
#pragma unroll
    for (int j = 0; j < 4; ++j) { const int cc = 16 * rb + 4 * fg + j; const float v = cc <= 126 ? o[j] : 0.f; dst[(size_t)cc * 128 + 16 * wave + fr] = (bf16_t)(cvt_pk_bf16(v, 0.f) & 0xffffu); }
    __syncthreads();
}

constexpr int DKS = 272, DVS = 288;
__device__ __forceinline__ void diff_item(int b, int h, int qb, const bf16_t* AP, bf16_t* OB, const float* subln, float lam, ldsp lds, int tid, int wave, int lane) {
    const int fr = lane & 15, g = lane >> 4;
    ldsp Ksh = lds, Vsh = lds + 64 * DKS;
    const LAS float* btab = (const LAS float*)(lds + 64 * DKS + 64 * DVS) + h * BT_N;
    const int t0 = 128 * qb, tq = t0 + 16 * wave + fr;
    const bf16_t* qrow = AP + (size_t)(b * T + tq) * APW + AC_DQ + h * 128;
    bf16x8 qf[2][2];
#pragma unroll
    for (int c = 0; c < 2; ++c)
#pragma unroll
        for (int ks = 0; ks < 2; ++ks) qf[c][ks] = *(const bf16x8*)(qrow + c * 64 + 32 * ks + 8 * g);
    f32x4 ot[2][8];
#pragma unroll
    for (int c = 0; c < 2; ++c)
#pragma unroll
        for (int nb = 0; nb < 8; ++nb) ot[c][nb] = (f32x4){0.f, 0.f, 0.f, 0.f};
    float m[2] = {NEGF, NEGF}, l[2] = {0.f, 0.f};
    const int ntile = 2 * qb + 2, tqmax = t0 + 16 * wave + 15;
    for (int kt = 0; kt < ntile; ++kt) {
        __syncthreads();
        stage_rows<64, 256>(Ksh, DKS, AP + (size_t)(b * T + 64 * kt) * APW + AC_DK + h * 128, APW, tid);
        stage_rows<64, 256>(Vsh, DVS, AP + (size_t)(b * T + 64 * kt) * APW + AC_DV + h * 128, APW, tid);
        __syncthreads();
        if (64 * kt > tqmax) continue;
        bf16x8 pf[2][2];
#pragma unroll
        for (int c = 0; c < 2; ++c) {
            f32x4 st[4];
            qk_tile<2>(st, Ksh + 128 * c, DKS, qf[c], fr, g);
#pragma unroll
            for (int a = 0; a < 4; ++a)
#pragma unroll
                for (int j = 0; j < 4; ++j) { const int kpos = 64 * kt + 32 * (a >> 1) + 8 * g + 4 * (a & 1) + j, d = tq - kpos;
                    st[a][j] = d >= 0 ? st[a][j] * 0.125f + btab[min(d, 128)] : NEGF; }
            softmax_step<8>(st, m[c], l[c], ot[c], pf[c][0], pf[c][1]);
        }
        { const int q = (lane & 15) >> 2, p = lane & 3; ldsp vb = Vsh + (8 * g + q) * DVS + 8 * p;
#pragma unroll
          for (int nb = 0; nb < 8; ++nb)
#pragma unroll
            for (int c2 = 0; c2 < 2; ++c2) { ldsp a = vb + 32 * c2 * DVS + 32 * nb; const s16x4 lo = vtr(a), hi = vtr(a + 4 * DVS);
                const bf16x8 vf = (bf16x8){lo[0], lo[1], lo[2], lo[3], hi[0], hi[1], hi[2], hi[3]};
                ot[0][nb] = __builtin_amdgcn_mfma_f32_16x16x32_bf16(vf, pf[0][c2], ot[0][nb], 0, 0, 0);
                ot[1][nb] = __builtin_amdgcn_mfma_f32_16x16x32_bf16(vf, pf[1][c2], ot[1][nb], 0, 0, 0); } }
    }
    float l0 = l[0], l1 = l[1];
    l0 += __shfl_xor(l0, 16); l0 += __shfl_xor(l0, 32); l1 += __shfl_xor(l1, 16); l1 += __shfl_xor(l1, 32);
    const float r0 = 1.f / l0, r1 = lam / l1;
    float ss = 0.f;
#pragma unroll
    for (int nb = 0; nb < 8; ++nb) { ot[0][nb] = ot[0][nb] * r0 - ot[1][nb] * r1; ss += (ot[0][nb][0] * ot[0][nb][0] + ot[0][nb][1] * ot[0][nb][1]) + (ot[0][nb][2] * ot[0][nb][2] + ot[0][nb][3] * ot[0][nb][3]); }
    ss += __shfl_xor(ss, 16); ss += __shfl_xor(ss, 32);
    const float rn = __builtin_amdgcn_rsqf(ss * (1.f / 128.f) + LN_EPS) * 0.8f;
    bf16_t* orow = OB + (size_t)(b * T + tq) * D + 1024 + h * 128;
#pragma unroll
    for (int nb = 0; nb < 8; ++nb) { const f32x4 sg = *(const f32x4*)(subln + 16 * nb + 4 * g); const f32x4 o = ot[0][nb] * rn * sg;
        u32x2 w; w.x = cvt_pk_bf16(o[0], o[1]); w.y = cvt_pk_bf16(o[2], o[3]); *(u32x2*)(orow + 16 * nb + 4 * g) = w; }
}

constexpr int NS_K = 0, NS_V = 128 * DKS, NS_BT = NS_V + 128 * DVS, NS_IM = NS_BT + 8 * BT_N * 4, NS_IH = NS_IM + 16384, NS_IF = NS_IH + 16384, NS_SM = NS_IF + 4096, NS_END = NS_SM + 128;
static_assert(NS_END <= 131072, "nsa lds");
template <int MODE  >
__device__ __forceinline__ void nsa_stream_tile(int kt0, int tq, unsigned selbit_ok, ldsp Ksh, ldsp Vsh, const LAS float* bt, const bf16x8* qf, float& m, float& l, f32x4* ot, int fr, int g, int lane) {
    f32x4 st[4];
    qk_tile<4>(st, Ksh, DKS, qf, fr, g);
#pragma unroll
    for (int a = 0; a < 4; ++a)
#pragma unroll
        for (int j = 0; j < 4; ++j) { const int kpos = kt0 + 32 * (a >> 1) + 8 * g + 4 * (a & 1) + j, d = tq - kpos;
            const bool ok = MODE == 1 ? (d >= 0 && selbit_ok) : (d >= 0 && d < 512);
            st[a][j] = ok ? st[a][j] * 0.08838834764831845f + bt[min(max(d, 0), 128)] : NEGF; }
    bf16x8 pf0, pf1;
    softmax_step<8>(st, m, l, ot, pf0, pf1);
    pv_tile<8>(ot, Vsh, DVS, pf0, pf1, lane);
}
__device__ __forceinline__ void nsa_item(int b, int grp, int qt, const bf16_t* AP, const bf16_t* CMP, bf16_t* OB, ldsp lds, int tid, int wave, int lane) {
    const int fr = lane & 15, g = lane >> 4, hh = wave >> 1, qs = wave & 1;
    ldsp Ksh = lds + NS_K, Vsh = lds + NS_V;
    const LAS float* bt = (const LAS float*)(lds + NS_BT) + (grp * 4 + hh) * BT_N;
    LAS float* impM = (LAS float*)(lds + NS_IM); LAS float* impH = (LAS float*)(lds + NS_IH); LAS float* impF = (LAS float*)(lds + NS_IF);
    LAS unsigned* selm = (LAS unsigned*)(lds + NS_SM);
    const int t0 = 32 * qt, ql = 16 * qs + fr, tq = t0 + ql, head = grp * 4 + hh, tblk = t0 >> 6;
    const size_t rowq = (size_t)(b * T + tq) * APW;
    bf16x8 qf[4];
#pragma unroll
    for (int ks = 0; ks < 4; ++ks) qf[ks] = *(const bf16x8*)(AP + rowq + AC_Q + head * 128 + 32 * ks + 8 * g);
    float gate[3];
#pragma unroll
    for (int r = 0; r < 3; ++r) { const float x = bf2f(AP[rowq + AC_GT + head * 3 + r]); gate[r] = __builtin_amdgcn_rcpf(1.f + __expf(-x)); }
    f32x4 res[8], ot[8];
    __syncthreads();
    stage_rows<128, 256>(Ksh, DKS, CMP + (size_t)((0 * 4 + b) * 2 + grp) * 128 * 128, 128, tid);
    stage_rows<128, 256>(Vsh, DVS, CMP + (size_t)((1 * 4 + b) * 2 + grp) * 128 * 128, 128, tid);
    __syncthreads();
    {
        f32x4 s0[4], s1[4];
        qk_tile<4>(s0, Ksh, DKS, qf, fr, g); qk_tile<4>(s1, Ksh + 64 * DKS, DKS, qf, fr, g);
        float mx = NEGF;
#pragma unroll
        for (int a = 0; a < 4; ++a)
#pragma unroll
            for (int j = 0; j < 4; ++j) { const int c0 = 32 * (a >> 1) + 8 * g + 4 * (a & 1) + j, c1 = c0 + 64; const int d0 = tq - (16 * c0 + 31), d1 = tq - (16 * c1 + 31);
                s0[a][j] = d0 >= 0 ? s0[a][j] * 0.08838834764831845f + bt[min(d0, 128)] : NEGF; s1[a][j] = d1 >= 0 ? s1[a][j] * 0.08838834764831845f + bt[min(d1, 128)] : NEGF;
                mx = fmaxf(mx, fmaxf(s0[a][j], s1[a][j])); }
        mx = fmaxf(mx, __shfl_xor(mx, 16)); mx = fmaxf(mx, __shfl_xor(mx, 32));
        float sum = 0.f;
#pragma unroll
        for (int a = 0; a < 4; ++a)
#pragma unroll
            for (int j = 0; j < 4; ++j) { s0[a][j] = __expf(s0[a][j] - mx); s1[a][j] = __expf(s1[a][j] - mx); sum += s0[a][j] + s1[a][j]; }
        sum += __shfl_xor(sum, 16); sum += __shfl_xor(sum, 32);
        const float inv = tq >= 31 ? 1.f / sum : 0.f;
#pragma unroll
        for (int a = 0; a < 4; ++a) { s0[a] = s0[a] * inv; s1[a] = s1[a] * inv; }
#pragma unroll
        for (int a = 0; a < 4; ++a) { const int J = 8 * (a >> 1) + 2 * g + (a & 1);
            impM[(hh * 32 + ql) * 32 + J] = (s0[a][0] + s0[a][1]) + (s0[a][2] + 0.5f * s0[a][3]); impH[(hh * 32 + ql) * 32 + J] = 0.5f * s0[a][3];
            impM[(hh * 32 + ql) * 32 + J + 16] = (s1[a][0] + s1[a][1]) + (s1[a][2] + 0.5f * s1[a][3]); impH[(hh * 32 + ql) * 32 + J + 16] = 0.5f * s1[a][3]; }
#pragma unroll
        for (int nb = 0; nb < 8; ++nb) ot[nb] = (f32x4){0.f, 0.f, 0.f, 0.f};
        pv_tile<8>(ot, Vsh, DVS, pack_bf8(s0[0], s0[1]), pack_bf8(s0[2], s0[3]), lane);
        pv_tile<8>(ot, Vsh + 64 * DVS, DVS, pack_bf8(s1[0], s1[1]), pack_bf8(s1[2], s1[3]), lane);
#pragma unroll
        for (int nb = 0; nb < 8; ++nb) res[nb] = ot[nb] * gate[0];
    }
    __syncthreads();
#pragma unroll
    for (int i = 0; i < 2; ++i) { const int e = tid + i * NTHR, q = e >> 5, J = e & 31; float s = 0.f;
#pragma unroll
        for (int h4 = 0; h4 < 4; ++h4) { s += impM[(h4 * 32 + q) * 32 + J]; if (J > 0) s += impH[(h4 * 32 + q) * 32 + J - 1]; }
        impF[q * 32 + J] = s; }
    __syncthreads();
    if (tid < 32) {
        unsigned chosen = 0u;
        for (int r = 0; r < 8; ++r) { float best = -1.f; int bi = -1;
            for (int j = 0; j <= tblk; ++j) { if ((chosen >> j) & 1u) continue; const float v = (j == 0 || j == tblk || j == tblk - 1) ? __builtin_inff() : impF[tid * 32 + j]; if (v > best) { best = v; bi = j; } }
            if (bi >= 0) chosen |= 1u << bi; }
        selm[tid] = chosen;
    }
    __syncthreads();
    unsigned uni = 0u;
#pragma unroll 8
    for (int q = 0; q < 32; ++q) uni |= selm[q];
    const unsigned mysel = selm[ql];
    {
        float m = NEGF, l = 0.f;
#pragma unroll
        for (int nb = 0; nb < 8; ++nb) ot[nb] = (f32x4){0.f, 0.f, 0.f, 0.f};
        for (int j = 0; j <= tblk; ++j) {
            if (!((uni >> j) & 1u)) continue;
            __syncthreads();
            stage_rows<64, 256>(Ksh, DKS, AP + (size_t)(b * T + 64 * j) * APW + AC_KS + grp * 128, APW, tid);
            stage_rows<64, 256>(Vsh, DVS, AP + (size_t)(b * T + 64 * j) * APW + AC_VS + grp * 128, APW, tid);
            __syncthreads();
            const unsigned mine = (mysel >> j) & 1u;
            if (__ballot(mine) == 0ull) continue;
            nsa_stream_tile<1>(64 * j, tq, mine, Ksh, Vsh, bt, qf, m, l, ot, fr, g, lane);
        }
        l += __shfl_xor(l, 16); l += __shfl_xor(l, 32);
        const float sc = gate[1] / l;
#pragma unroll
        for (int nb = 0; nb < 8; ++nb) res[nb] = res[nb] + ot[nb] * sc;
    }
    {
        float m = NEGF, l = 0.f;
#pragma unroll
        for (int nb = 0; nb < 8; ++nb) ot[nb] = (f32x4){0.f, 0.f, 0.f, 0.f};
        const int kt_lo = max(0, (t0 - 511) >> 6);
        for (int kt = kt_lo; kt <= tblk; ++kt) {
            __syncthreads();
            stage_rows<64, 256>(Ksh, DKS, AP + (size_t)(b * T + 64 * kt) * APW + AC_KW + grp * 128, APW, tid);
            stage_rows<64, 256>(Vsh, DVS, AP + (size_t)(b * T + 64 * kt) * APW + AC_VW + grp * 128, APW, tid);
            __syncthreads();
            nsa_stream_tile<2>(64 * kt, tq, 1u, Ksh, Vsh, bt, qf, m, l, ot, fr, g, lane);
        }
        l += __shfl_xor(l, 16); l += __shfl_xor(l, 32);
        const float sc = gate[2] / l;
#pragma unroll
        for (int nb = 0; nb < 8; ++nb) res[nb] = res[nb] + ot[nb] * sc;
    }
    bf16_t* orow = OB + (size_t)(b * T + tq) * D + head * 128;
#pragma unroll
    for (int nb = 0; nb < 8; ++nb) { u32x2 w; w.x = cvt_pk_bf16(res[nb][0], res[nb][1]); w.y = cvt_pk_bf16(res[nb][2], res[nb][3]); *(u32x2*)(orow + 16 * nb + 4 * g) = w; }
}

constexpr int RKS = 528, RVS = 1056;
static_assert(64 * RKS + 64 * RVS <= 131072, "ret lds");
__device__ __forceinline__ void ret_item(int b, int h, int qb, const bf16_t* RP, bf16_t* OB, ldsp lds, int tid, int wave, int lane) {
    const int fr = lane & 15, g = lane >> 4;
    ldsp Ksh = lds, Vsh = lds + 64 * RKS;
    const int t0 = 128 * qb, tq = t0 + 16 * wave + fr, tqmax = t0 + 16 * wave + 15;
    const size_t rowq = (size_t)(b * T + tq) * RPW;
    bf16x8 qf[8];
#pragma unroll
    for (int ks = 0; ks < 8; ++ks) qf[ks] = *(const bf16x8*)(RP + rowq + h * 256 + 32 * ks + 8 * g);
    f32x4 ot[32];
#pragma unroll
    for (int nb = 0; nb < 32; ++nb) ot[nb] = (f32x4){0.f, 0.f, 0.f, 0.f};
    const float lg2 = log2f(1.0f - exp2f(-5.0f - (float)h));
    const int ntile = 2 * qb + 2;
    for (int kt = 0; kt < ntile; ++kt) {
        __syncthreads();
        stage_rows<64, 512>(Ksh, RKS, RP + (size_t)(b * T + 64 * kt) * RPW + 2048 + h * 256, RPW, tid);
        stage_rows<64, 1024>(Vsh, RVS, RP + (size_t)(b * T + 64 * kt) * RPW + 4096 + h * 512, RPW, tid);
        __syncthreads();
        if (64 * kt > tqmax) continue;
        f32x4 st[4];
        qk_tile<8>(st, Ksh, RKS, qf, fr, g);
#pragma unroll
        for (int a = 0; a < 4; ++a)
#pragma unroll
            for (int j = 0; j < 4; ++j) { const int kpos = 64 * kt + 32 * (a >> 1) + 8 * g + 4 * (a & 1) + j, d = tq - kpos;
                st[a][j] = d >= 0 ? st[a][j] * exp2f((float)d * lg2) : 0.f; }
        pv_tile<32>(ot, Vsh, RVS, pack_bf8(st[0], st[1]), pack_bf8(st[2], st[3]), lane);
    }
    float s = 0.f;
#pragma unroll
    for (int nb = 0; nb < 32; ++nb) s += (ot[nb][0] + ot[nb][1]) + (ot[nb][2] + ot[nb][3]);
    s += __shfl_xor(s, 16); s += __shfl_xor(s, 32);
    const float mu = s * (1.f / 512.f); float s2 = 0.f;
#pragma unroll
    for (int nb = 0; nb < 32; ++nb) { ot[nb] = ot[nb] - mu; s2 += (ot[nb][0] * ot[nb][0] + ot[nb][1] * ot[nb][1]) + (ot[nb][2] * ot[nb][2] + ot[nb][3] * ot[nb][3]); }
    s2 += __shfl_xor(s2, 16); s2 += __shfl_xor(s2, 32);
    const float rstd = __builtin_amdgcn_rsqf(s2 * (1.f / 512.f) + LN_EPS);
    const bf16_t* grow = RP + rowq + 8192 + h * 512;
    bf16_t* orow = OB + (size_t)(b * T + tq) * 4096 + h * 512;
#pragma unroll
    for (int nb = 0; nb < 32; ++nb) { const u32x2 gr = *(const u32x2*)(grow + 16 * nb + 4 * g);
        const float g0 = __uint_as_float(gr.x << 16), g1 = __uint_as_float(gr.x & 0xffff0000u), g2 = __uint_as_float(gr.y << 16), g3 = __uint_as_float(gr.y & 0xffff0000u);
        u32x2 w; w.x = cvt_pk_bf16(ot[nb][0] * rstd * g0, ot[nb][1] * rstd * g1); w.y = cvt_pk_bf16(ot[nb][2] * rstd * g2, ot[nb][3] * rstd * g3); *(u32x2*)(orow + 16 * nb + 4 * g) = w; }
}

#define XB_TMO      128
#define XB_XCNT(j)  (256  + 64 * (j))
#define XB_XSUB(j)  (1280 + 64 * (j))
#define XB_XGEN(j)  (2304 + 64 * (j))
#define XB_TOP      3328
#define XB_TOPGEN   3392
#define XCD_BAR_WORDS 3456
#define XB_SPIN_CAP (1u << 18)

__device__ __forceinline__ unsigned xb_ld(unsigned* p)              { return __hip_atomic_load(p, __ATOMIC_RELAXED, __HIP_MEMORY_SCOPE_AGENT); }
__device__ __forceinline__ unsigned xb_add(unsigned* p, unsigned v) { return __hip_atomic_fetch_add(p, v, __ATOMIC_RELAXED, __HIP_MEMORY_SCOPE_AGENT); }
__device__ __forceinline__ unsigned xb_xcc_id() { return (unsigned)__builtin_amdgcn_s_getreg((3 << 11) | 20) & 0xFu; }
#define XB_SPIN(cond, bar) do { unsigned _sp = 0; while (cond) { __builtin_amdgcn_s_sleep(1); \
    if ((++_sp & 255u) == 0u) { if (xb_ld(&(bar)[XB_TMO])) break; if (_sp > XB_SPIN_CAP) { atomicAdd(&(bar)[XB_TMO], 1u); break; } } } } while (0)

struct XcdBarrier {
    unsigned* bar; unsigned x;
    volatile LAS unsigned* st;
};

__device__ __forceinline__ XcdBarrier xcd_barrier_post(unsigned* bar, volatile LAS unsigned* st) {
    XcdBarrier b; b.bar = bar; b.x = xb_xcc_id(); b.st = st;
    if (threadIdx.x == 0) (void)xb_add(&bar[XB_XCNT(b.x)], 1u);
    return b;
}
__device__ __forceinline__ void xcd_barrier_complete(unsigned* bar, unsigned x, unsigned& nloc, unsigned& nx) {
    const unsigned G = gridDim.x * gridDim.y * gridDim.z;
    unsigned sum, cnt, mine, sp = 0u;
    for (;;) {
        sum = 0u; cnt = 0u; mine = 0u;
#pragma unroll
        for (unsigned j = 0; j < 16; ++j) { const unsigned c = xb_ld(&bar[XB_XCNT(j)]); sum += c; cnt += (c > 0u) ? 1u : 0u; mine = (j == x) ? c : mine; }
        if (sum == G) break;
        __builtin_amdgcn_s_sleep(1);
        if ((++sp & 255u) == 0u) { if (xb_ld(&bar[XB_TMO])) break; if (sp > XB_SPIN_CAP) { atomicAdd(&bar[XB_TMO], 1u); break; } }
    }
    nloc = mine > 0u ? mine : 1u; nx = cnt > 0u ? cnt : 1u;
}

__device__ __forceinline__ void xcd_barrier(const XcdBarrier& b) {
    asm volatile("s_waitcnt vmcnt(0)" ::: "memory");
    __syncthreads();
    if (threadIdx.x == 0) {
        unsigned* bar = b.bar;
        __builtin_amdgcn_s_waitcnt(0);
        unsigned nloc = b.st[0], nx = b.st[1];
        if (nloc == 0u) { xcd_barrier_complete(bar, b.x, nloc, nx); b.st[0] = nloc; b.st[1] = nx; }
        const unsigned old = xb_add(&bar[XB_XSUB(b.x)], 1u);
        const unsigned gen = old / nloc;
        if (old + 1u == (gen + 1u) * nloc) {
            __builtin_amdgcn_fence(__ATOMIC_RELEASE, "agent");
            asm volatile("s_waitcnt vmcnt(0)" ::: "memory");
            const unsigned og = xb_add(&bar[XB_TOP], 1u);
            const unsigned tg = og / nx;
            if (og + 1u == (tg + 1u) * nx) xb_add(&bar[XB_TOPGEN], 1u);
            else XB_SPIN(xb_ld(&bar[XB_TOPGEN]) == tg, bar);
            __builtin_amdgcn_fence(__ATOMIC_ACQUIRE, "agent");
            xb_add(&bar[XB_XGEN(b.x)], 1u);
            asm volatile("s_waitcnt vmcnt(0)" ::: "memory");
        } else {
            XB_SPIN(xb_ld(&bar[XB_XGEN(b.x)]) == gen, bar);
            __builtin_amdgcn_fence(__ATOMIC_ACQUIRE, "agent");
            asm volatile("s_waitcnt vmcnt(0)" ::: "memory");
        }
    }
    __syncthreads();
}

struct Args { const float* in[18]; float* out; unsigned char* ws; };
__global__ void __launch_bounds__(NTHR, 2) fwd_megakernel(Args args) {
    extern __shared__ __attribute__((aligned(16))) unsigned char lds_raw[];
    cg::grid_group grid = cg::this_grid();
    ldsp lds = (ldsp)lds_raw;
    const int G = gridDim.x, bx = blockIdx.x, ngw = G * NWAVES;
    { volatile LAS unsigned* misc = (volatile LAS unsigned*)(lds + MISC_OFF); if (threadIdx.x < 16) misc[threadIdx.x] = 0u; }
    __syncthreads();
    const XcdBarrier xbar = xcd_barrier_post((unsigned*)(args.ws + WS_CTL), (volatile LAS unsigned*)(lds + MISC_OFF));
#define GSYNC() xcd_barrier(xbar)
#define PHASE_IDS() int tid = threadIdx.x; asm volatile("" : "+v"(tid)); const int lane = tid & 63, wave = __builtin_amdgcn_readfirstlane(tid >> 6), gw = bx * NWAVES + wave; (void)lane; (void)gw;
#define OPQ(p) ({ auto _p = (p); asm volatile("" : "+s"(_p)); _p; })
#define WSP(TY, off) ((TY*)(OPQ(args.ws) + (off)))
#define INP(i) ((const float*)OPQ(args.in[i]))
#define x_in INP(0)
#define ffn_w_in INP(1)
#define ffn_w_out INP(2)
#define ln_gain INP(3)
#define ln_bias INP(4)
#define rel_bias INP(5)
#define a_w_in INP(6)
#define a_w_out INP(7)
#define cmp_pos INP(8)
#define cmp_w1 INP(9)
#define cmp_w2 INP(10)
#define ret_w_in INP(16)
#define ret_w_out INP(17)
#define WFI WSP(bf16_t, WS_WFI)
#define WFO WSP(bf16_t, WS_WFO)
#define WAI WSP(bf16_t, WS_WAI)
#define WAO WSP(bf16_t, WS_WAO)
#define WRI WSP(bf16_t, WS_WRI)
#define WRO WSP(bf16_t, WS_WRO)
#define W1T WSP(bf16_t, WS_W1T)
#define W2T WSP(bf16_t, WS_W2T)
#define ROPE_C WSP(float, WS_ROPE)
#define ROPE_S WSP(float, WS_ROPE + (size_t)T * 128 * 4)
#define XB WSP(bf16_t, WS_XB)
#define XF WSP(float, WS_XF)
#define Y WSP(float, WS_Y)
#define HB WSP(bf16_t, WS_H)
#define AP WSP(bf16_t, WS_AP)
#define RP WSP(bf16_t, WS_RP)
#define OB WSP(bf16_t, WS_OB)
#define CMP WSP(bf16_t, WS_CMP)

    {
        PHASE_IDS();
        LAS float* scr = (LAS float*)(lds + wave * 16640);
        for (int f = 0; f < 4; ++f) {
            transpose_mat(ffn_w_in + (size_t)f * D * 2 * FF, D, 2 * FF, WFI + (size_t)f * 2 * FF * D, 1, scr, gw, ngw, lane);
            transpose_mat(ffn_w_out + (size_t)f * FF * D, FF, D, WFO + (size_t)f * D * FF, 0, scr, gw, ngw, lane);
        }
        transpose_mat(a_w_in, D, 5656, WAI, 2, scr, gw, ngw, lane);
        transpose_mat(a_w_out, D, D, WAO, 0, scr, gw, ngw, lane);
        transpose_mat(ret_w_in, D, RPW, WRI, 0, scr, gw, ngw, lane);
        transpose_mat(ret_w_out, 4096, D, WRO, 0, scr, gw, ngw, lane);
        for (int kv = 0; kv < 2; ++kv) {
            transpose_mat(cmp_w1 + (size_t)kv * 4096 * 128, 4096, 128, W1T + (size_t)kv * 128 * 4096, 0, scr, gw, ngw, lane);
            transpose_mat(cmp_w2 + (size_t)kv * 128 * 128, 128, 128, W2T + (size_t)kv * 128 * 128, 0, scr, gw, ngw, lane);
        }
        const size_t gt = (size_t)bx * NTHR + tid, ngt = (size_t)G * NTHR;
        { bf16_t* wai = WAI; for (size_t i = gt; i < (size_t)(APW - 5656) * D / 8; i += ngt) *(u32x4*)(wai + (size_t)5656 * D + i * 8) = (u32x4){0u, 0u, 0u, 0u}; }
        { const float* xi = x_in; bf16_t* xb = XB; for (size_t i = gt; i < (size_t)M * D / 4; i += ngt) { const f32x4 v = *(const f32x4*)(xi + i * 4); u32x2 w; w.x = cvt_pk_bf16(v.x, v.y); w.y = cvt_pk_bf16(v.z, v.w); *(u32x2*)(xb + i * 4) = w; } }
        float* rc = ROPE_C; float* rs = ROPE_S;
        for (size_t i = gt; i < (size_t)T * 128; i += ngt) { const int t = (int)(i >> 7), j = (int)(i & 127);
            const float inv = powf(10000.0f, -(float)j * (1.0f / 128.0f)); const float ang = (float)t * inv;
            const double rev = (double)ang * 0.15915494309189535; const float frac = (float)(rev - floor(rev));
            rc[i] = __builtin_amdgcn_cosf(frac); rs[i] = __builtin_amdgcn_sinf(frac); }
    }
    grid.sync();

    pg8::StaticOrder S;
    for (int li = 0; li < 2; ++li) {
        for (int sub = 0; sub < 3; ++sub) {
            const bf16_t* rA; const bf16_t* rB; int rK; float rsc;
            if (sub != 1) {
                const int f = li * 2 + (sub == 2 ? 1 : 0);
                { pg8::Gemm gm{XB, WFI + (size_t)f * 2 * FF * D, M, 2 * FF, D}; S.init(M, 2 * FF, G, bx); pg8::EpiSwiGLU E{HB, FF};

#ifndef NO_G1
 pg8::gemm_phase<pg8::EpiSwiGLU, pg8::StaticOrder, true, true>(lds, gm, S, E);
#endif
 }
                GSYNC();
                rA = HB; rB = WFO + (size_t)f * D * FF; rK = FF; rsc = 0.5f;
            } else if (li == 0) {
                { pg8::Gemm gm{XB, WAI, M, APW, D}; S.init(M, APW, G, bx); pg8::EpiPlain E{AP, APW};

#ifndef NO_G2
 pg8::gemm_phase<pg8::EpiPlain, pg8::StaticOrder, true, true>(lds, gm, S, E);
#endif
 }
                GSYNC();
                { PHASE_IDS();
#ifndef NO_CMP
                for (int it = bx; it < 128; it += G) compress_item(it, AP, cmp_pos, W1T, W2T, CMP, lds, tid, wave, lane);
#endif
                {
                    float lam;
                    { const float a = wave_sum(INP(11)[lane] * INP(12)[lane]), c = wave_sum(INP(13)[lane] * INP(14)[lane]); lam = expf(a) - expf(c) + 0.2f; }
                    __syncthreads();
                    fill_btab((LAS float*)(lds + 64 * DKS + 64 * DVS), rel_bias, 8, 8, tid);
                    __syncthreads();
                    for (int it = bx; it < 256; it += G) { const int bh = it >> 3, s8 = it & 7, b = bh >> 3, h = bh & 7;
#ifndef NO_DIFF
                        diff_item(b, h, s8, AP, OB, INP(15), lam, lds + 0, tid, wave, lane);
                        diff_item(b, h, 15 - s8, AP, OB, INP(15), lam, lds + 0, tid, wave, lane);
#endif
                    }
                }
                }
                GSYNC();
                { PHASE_IDS();
                __syncthreads();
                fill_btab((LAS float*)(lds + NS_BT), rel_bias, 0, 8, tid);
                __syncthreads();
                for (int it = bx; it < 256; it += G) { const int bg = it >> 5, s32 = it & 31, b = bg >> 1, grp = bg & 1;
#ifndef NO_NSA
                    nsa_item(b, grp, s32, AP, CMP, OB, lds, tid, wave, lane);
                    nsa_item(b, grp, 63 - s32, AP, CMP, OB, lds, tid, wave, lane);
#endif
                }
                }
                GSYNC();
                rA = OB; rB = WAO; rK = D; rsc = 1.0f;
            } else {
                { pg8::Gemm gm{XB, WRI, M, RPW, D}; S.init(M, RPW, G, bx); pg8::EpiRet E{RP, RPW, ROPE_C, ROPE_S, T};

#ifndef NO_G3
 pg8::gemm_phase<pg8::EpiRet, pg8::StaticOrder, true, true>(lds, gm, S, E);
#endif
 }
                GSYNC();
                { PHASE_IDS();
                for (int it = bx; it < 256; it += G) { const int bh = it >> 3, s8 = it & 7, b = bh >> 3, h = bh & 7;
#ifndef NO_RET
                    ret_item(b, h, s8, RP, OB, lds, tid, wave, lane);
                    ret_item(b, h, 15 - s8, RP, OB, lds, tid, wave, lane);
#endif
                }
                }
                GSYNC();
                rA = OB; rB = WRO; rK = 4096; rsc = 1.0f;
            }
            { pg8::Gemm gm{rA, rB, M, D, rK}; S.init(M, D, G, bx); const float* rres = (li == 0 && sub == 0) ? x_in : (const float*)XF; pg8::EpiResid E{Y, rres, D, ALPHA, rsc};

#ifndef NO_G4
 pg8::gemm_phase<pg8::EpiResid, pg8::StaticOrder, false, true>(lds, gm, S, E);
#endif
 }
            GSYNC();
            const bool last = (li == 1 && sub == 2);
            { PHASE_IDS();
            ln_phase(Y, ln_gain + (size_t)(li * 3 + sub) * D, ln_bias + (size_t)(li * 3 + sub) * D, last ? args.out : (float*)XF, last ? (bf16_t*)nullptr : (bf16_t*)XB, gw, ngw, lane); }
            if (!last) GSYNC();
        }
    }
}

extern "C" void kernel_launch(void* const* d_in, const int* in_sizes, int n_in, void* d_out, int out_size, void* d_ws, size_t ws_size, hipStream_t stream) {
    static int grid = 0;
    if (grid == 0) {
        if (n_in != 18 || out_size != M * D || ws_size < WS_END) { fprintf(stderr, "kernel_launch: unexpected shapes (n_in %d out %d ws %zu)\n", n_in, out_size, ws_size); grid = -1; return; }
        int dev = 0, cus = 0, per_cu = 0;
        hipGetDevice(&dev); hipDeviceGetAttribute(&cus, hipDeviceAttributeMultiprocessorCount, dev);
        if (hipFuncSetAttribute((const void*)fwd_megakernel, hipFuncAttributeMaxDynamicSharedMemorySize, LDS_BYTES) != hipSuccess) { fprintf(stderr, "kernel_launch: hipFuncSetAttribute failed\n"); grid = -1; return; }
        if (hipOccupancyMaxActiveBlocksPerMultiprocessor(&per_cu, (const void*)fwd_megakernel, NTHR, LDS_BYTES) != hipSuccess || per_cu < 1) { fprintf(stderr, "kernel_launch: occupancy query %d\n", per_cu); per_cu = 1; }
        (void)hipGetLastError();
        grid = cus * 1;
        if (grid > 256) grid = 256;
    }
    if (grid < 0) return;
    if (hipMemsetAsync((char*)d_ws + WS_CTL, 0, 16384, stream) != hipSuccess) { fprintf(stderr, "kernel_launch: memset failed\n"); return; }
    Args a{};
    for (int i = 0; i < 18; ++i) a.in[i] = (const float*)d_in[i];
    a.out = (float*)d_out; a.ws = (unsigned char*)d_ws;
    void* kargs[] = {&a};
    hipError_t e = hipLaunchCooperativeKernel((const void*)fwd_megakernel, dim3(grid), dim3(NTHR), kargs, LDS_BYTES, stream);
    if (e != hipSuccess) fprintf(stderr, "kernel_launch: cooperative launch failed: %s (grid %d)\n", hipGetErrorString(e), grid);
}
```
